# Optimizing an MI355X kernel written in HIP

```python
import jax, jax.numpy as jnp
from jax import lax
import numpy as np

D_MODEL = 1024
BATCH = 8
SEQ = 2048
DEPTH = 4

GRID_W = 64
CTX_LEN = 256
EPS = 1e-6

MIX_WIDTH = D_MODEL
FOURIER_WIDTH = MIX_WIDTH // 4
N_FOURIER_HEADS = 4
FOURIER_HEAD_DIM = FOURIER_WIDTH // N_FOURIER_HEADS
POOL_WIDTH = MIX_WIDTH // 4
POOL_WINDOWS = (2, 4, 8, 16)
POOL_GROUP_DIM = POOL_WIDTH // len(POOL_WINDOWS)
ATTN_WIDTH = MIX_WIDTH // 2
HEAD_DIM = 128
N_Q_HEADS = ATTN_WIDTH // HEAD_DIM
N_KV_HEADS = 2
Q_PER_KV = N_Q_HEADS // N_KV_HEADS
KV_WIDTH = N_KV_HEADS * HEAD_DIM
ROPE_HALF = HEAD_DIM // 2
ROPE_THETA = 10000.0
Q_BLOCK = 128

F_OFF = 0
P_OFF = F_OFF + FOURIER_WIDTH
Q_OFF = P_OFF + POOL_WIDTH
K_OFF = Q_OFF + ATTN_WIDTH
V_OFF = K_OFF + KV_WIDTH
IN_WIDTH = V_OFF + KV_WIDTH

N_EXPERTS = 16
EC_CAPACITY_FACTOR = 2
EXPERT_FF = D_MODEL

kernel_name = "hybrid_fourier_pool_gqa_ec_moe_dit"


def rms_norm(x, g):
    xf = x.astype(jnp.float32)
    y = xf * lax.rsqrt(jnp.mean(xf * xf, axis=-1, keepdims=True) + EPS)
    return (y * g.astype(jnp.float32)).astype(x.dtype)


def modulate(x, g, shift, scale):
    xf = x.astype(jnp.float32)
    y = xf * lax.rsqrt(jnp.mean(xf * xf, axis=-1, keepdims=True) + EPS) * g.astype(jnp.float32)
    y = y * (1.0 + scale.astype(jnp.float32)) + shift.astype(jnp.float32)
    return y.astype(x.dtype)


def axial_angles(n):
    rows = n // GRID_W
    row = jnp.repeat(jnp.arange(rows, dtype=jnp.float32), GRID_W)
    col = jnp.tile(jnp.arange(GRID_W, dtype=jnp.float32), rows)
    inv = ROPE_THETA ** (-jnp.arange(0, ROPE_HALF, 2, dtype=jnp.float32) / ROPE_HALF)
    return row[:, None] * inv[None, :], col[:, None] * inv[None, :]


def rope_half(x, ang):
    cos = jnp.cos(ang)[None, :, None, :]
    sin = jnp.sin(ang)[None, :, None, :]
    xf = x.astype(jnp.float32)
    x1, x2 = xf[..., : ROPE_HALF // 2], xf[..., ROPE_HALF // 2:]
    return jnp.concatenate([x1 * cos - x2 * sin, x2 * cos + x1 * sin], axis=-1).astype(x.dtype)


def axial_rope(x, ang_row, ang_col):
    return jnp.concatenate([rope_half(x[..., :ROPE_HALF], ang_row),
                            rope_half(x[..., ROPE_HALF:], ang_col)], axis=-1)


def attend(q, k, v):
    s = jnp.einsum('bqhgd,bkhd->bhgqk', q, k).astype(jnp.float32) * (HEAD_DIM ** -0.5)
    p = jax.nn.softmax(s, axis=-1).astype(v.dtype)
    return jnp.einsum('bhgqk,bkhd->bqhgd', p, v)


def blocked_attention(q, k, v):
    B, L = q.shape[0], q.shape[1]
    nb = L // Q_BLOCK
    qb = q.reshape(B, nb, Q_BLOCK, N_KV_HEADS, Q_PER_KV, HEAD_DIM).transpose(1, 0, 2, 3, 4, 5)
    ob = lax.map(lambda qi: attend(qi, k, v), qb)
    return ob.transpose(1, 0, 2, 3, 4, 5).reshape(B, L, ATTN_WIDTH)


def fourier_mix(f, w):
    B, n, _ = f.shape
    fh = f.astype(jnp.float32).reshape(B, n, N_FOURIER_HEADS, FOURIER_HEAD_DIM).transpose(0, 2, 1, 3)
    fr = jnp.real(jnp.fft.fft2(fh, axes=(-2, -1), norm="ortho"))
    fr = fr.transpose(0, 2, 1, 3).reshape(B, n, FOURIER_WIDTH).astype(f.dtype)
    return fr @ w


def pool_mix(p, w, scale):
    B, n, _ = p.shape
    pf = p.astype(jnp.float32)
    cs = jnp.concatenate([jnp.zeros((B, 1, POOL_WIDTH), jnp.float32), jnp.cumsum(pf, axis=1)], axis=1)
    t = jnp.arange(n)
    outs = []
    for gi, win in enumerate(POOL_WINDOWS):
        lo = jnp.clip(t - win // 2, 0, n)
        hi = jnp.clip(t + win // 2, 0, n)
        sl = slice(gi * POOL_GROUP_DIM, (gi + 1) * POOL_GROUP_DIM)
        csg = cs[..., sl]
        s = jnp.take(csg, hi, axis=1) - jnp.take(csg, lo, axis=1)
        cnt = (hi - lo).astype(jnp.float32)[None, :, None]
        outs.append(s / cnt - pf[..., sl])
    d = jnp.stack(outs, axis=2).astype(p.dtype)
    y = jnp.einsum('bngc,gcd->bngd', d, w).reshape(B, n, POOL_WIDTH)
    return y * scale


def expert_choice_ffn(h, w_router, w_gate, w_up, w_down):
    B, n, D = h.shape
    cap = EC_CAPACITY_FACTOR * n // N_EXPERTS
    logits = jnp.einsum('bnd,de->bne', h, w_router).astype(jnp.float32)
    aff = jax.nn.softmax(logits, axis=-1)
    g, idx = lax.top_k(aff.transpose(0, 2, 1), cap)
    xs = jax.vmap(lambda hb, ib: hb[ib])(h, idx)
    a = jnp.einsum('becd,edf->becf', xs, w_gate)
    u = jnp.einsum('becd,edf->becf', xs, w_up)
    y = jnp.einsum('becf,efd->becd', jax.nn.silu(a) * u, w_down)
    y = y * g[..., None].astype(y.dtype)
    return jax.vmap(lambda yb, ib: jnp.zeros((n, D), yb.dtype).at[ib.reshape(-1)].add(yb.reshape(-1, D)))(y, idx)


def setup_inputs(seed: int = 0) -> dict:
    key = jax.random.key(seed)
    ks = jax.random.split(key, 20)
    nrm = jax.random.normal
    f32 = jnp.float32
    D = D_MODEL
    return {
        "x": nrm(ks[0], (BATCH, SEQ, D), f32),
        "c": nrm(ks[1], (BATCH, D), f32),
        "ctx": nrm(ks[2], (BATCH, CTX_LEN, D), f32),
        "c_ctx": nrm(ks[3], (D,), f32),
        "ada_w": nrm(ks[4], (DEPTH, D, 6 * D), f32) * (0.5 * D ** -0.5),
        "ada_b": nrm(ks[5], (DEPTH, 6 * D), f32) * 0.02,
        "norm1_g": 1.0 + 0.02 * nrm(ks[6], (DEPTH, D), f32),
        "norm2_g": 1.0 + 0.02 * nrm(ks[7], (DEPTH, D), f32),
        "w_in": nrm(ks[8], (DEPTH, D, IN_WIDTH), f32) * D ** -0.5,
        "w_fourier": nrm(ks[9], (DEPTH, FOURIER_WIDTH, FOURIER_WIDTH), f32) * FOURIER_WIDTH ** -0.5,
        "w_pool": nrm(ks[10], (DEPTH, len(POOL_WINDOWS), POOL_GROUP_DIM, POOL_GROUP_DIM), f32) * POOL_GROUP_DIM ** -0.5,
        "pool_scale": 1.0 + 0.1 * nrm(ks[11], (DEPTH, POOL_WIDTH), f32),
        "q_norm_g": 1.0 + 0.02 * nrm(ks[12], (DEPTH, HEAD_DIM), f32),
        "k_norm_g": 1.0 + 0.02 * nrm(ks[13], (DEPTH, HEAD_DIM), f32),
        "w_out": nrm(ks[14], (DEPTH, MIX_WIDTH, D), f32) * MIX_WIDTH ** -0.5,
        "w_router": nrm(ks[15], (DEPTH, D, N_EXPERTS), f32) * D ** -0.5,
        "w_gate": nrm(ks[16], (DEPTH, N_EXPERTS, D, EXPERT_FF), f32) * D ** -0.5,
        "w_up": nrm(ks[17], (DEPTH, N_EXPERTS, D, EXPERT_FF), f32) * D ** -0.5,
        "w_down": nrm(ks[18], (DEPTH, N_EXPERTS, EXPERT_FF, D), f32) * EXPERT_FF ** -0.5,
    }


def reference(x, c, ctx, c_ctx, ada_w, ada_b, norm1_g, norm2_g, w_in, w_fourier, w_pool, pool_scale,
              q_norm_g, k_norm_g, w_out, w_router, w_gate, w_up, w_down):
    B, L, D = x.shape
    Lc = ctx.shape[1]
    ang_row, ang_col = axial_angles(L)
    sc = jax.nn.silu(c)
    scc = jax.nn.silu(c_ctx)
    for i in range(DEPTH):
        last = i == DEPTH - 1
        sh1, sc1, g1, sh2, sc2, g2 = jnp.split((sc @ ada_w[i] + ada_b[i])[:, None, :], 6, axis=-1)
        csh1, csc1, cg1, csh2, csc2, cg2 = jnp.split((scc @ ada_w[i] + ada_b[i])[None, None, :], 6, axis=-1)

        hx = modulate(x, norm1_g[i], sh1, sc1)
        hc = modulate(ctx, norm1_g[i], csh1, csc1)
        px_all = hx @ w_in[i]
        kvc = hc @ w_in[i][:, K_OFF:]
        kc = rms_norm(kvc[..., :KV_WIDTH].reshape(B, Lc, N_KV_HEADS, HEAD_DIM), k_norm_g[i])
        vc = kvc[..., KV_WIDTH:].reshape(B, Lc, N_KV_HEADS, HEAD_DIM)

        qx = rms_norm(px_all[..., Q_OFF:K_OFF].reshape(B, L, N_Q_HEADS, HEAD_DIM), q_norm_g[i])
        kx = rms_norm(px_all[..., K_OFF:V_OFF].reshape(B, L, N_KV_HEADS, HEAD_DIM), k_norm_g[i])
        vx = px_all[..., V_OFF:].reshape(B, L, N_KV_HEADS, HEAD_DIM)
        qx = axial_rope(qx, ang_row, ang_col)
        kx = axial_rope(kx, ang_row, ang_col)
        k_all = jnp.concatenate([kx, kc], axis=1)
        v_all = jnp.concatenate([vx, vc], axis=1)
        ax = blocked_attention(qx, k_all, v_all)
        ox = jnp.concatenate([fourier_mix(px_all[..., F_OFF:P_OFF], w_fourier[i]),
                              pool_mix(px_all[..., P_OFF:Q_OFF], w_pool[i], pool_scale[i]),
                              ax], axis=-1) @ w_out[i]
        x_new = x + g1 * ox

        x_new = x_new + g2 * expert_choice_ffn(modulate(x_new, norm2_g[i], sh2, sc2),
                                               w_router[i], w_gate[i], w_up[i], w_down[i])

        if not last:
            pc_all = hc @ w_in[i][:, :K_OFF]
            qc = rms_norm(pc_all[..., Q_OFF:K_OFF].reshape(B, Lc, N_KV_HEADS, Q_PER_KV, HEAD_DIM), q_norm_g[i])
            ac = attend(qc, kc, vc).reshape(B, Lc, ATTN_WIDTH)
            oc = jnp.concatenate([fourier_mix(pc_all[..., F_OFF:P_OFF], w_fourier[i]),
                                  pool_mix(pc_all[..., P_OFF:Q_OFF], w_pool[i], pool_scale[i]),
                                  ac], axis=-1) @ w_out[i]
            ctx = ctx + cg1 * oc
            ctx = ctx + cg2 * expert_choice_ffn(modulate(ctx, norm2_g[i], csh2, csc2),
                                                w_router[i], w_gate[i], w_up[i], w_down[i])
        x = x_new
    return x
```

```cpp
#include <hip/hip_runtime.h>
#include <hip/hip_cooperative_groups.h>
#include <cstdio>
#include <cstdint>
namespace cg = cooperative_groups;

typedef unsigned short bf16_t;
typedef short bf16x8 __attribute__((ext_vector_type(8)));
typedef short s16x4 __attribute__((ext_vector_type(4)));
typedef float f32x4 __attribute__((ext_vector_type(4)));
typedef float f32x16 __attribute__((ext_vector_type(16)));
typedef unsigned u32x4 __attribute__((ext_vector_type(4)));
typedef unsigned u32x2 __attribute__((ext_vector_type(2)));
#define LAS __attribute__((address_space(3)))

constexpr int DM = 1024, NB = 8, SEQ = 2048, CTXL = 256, NLAT = NB * SEQ, NCTX = NB * CTXL, NTOK = NLAT + NCTX, DEPTH = 4;
constexpr int NE = 16, CAPL = 256, CAPC = 32, EROWS = NB * CAPL + NB * CAPC;
constexpr int KVLEN = SEQ + CTXL;
constexpr float EPS = 1e-6f;
constexpr int NTHR = 512, NWAVE = 8;
constexpr int LDS_BYTES = 132 * 1024;
constexpr int CONV_SPLIT = 11264;

enum { I_X = 0, I_C, I_CTX, I_CCTX, I_ADAW, I_ADAB, I_N1G, I_N2G, I_WIN, I_WFOU, I_WPOOL, I_PSCALE, I_QG, I_KG, I_WOUT, I_WROUTER, I_WGATE, I_WUP, I_WDOWN, N_IN };
struct Params { const float* in[N_IN]; float* out; unsigned char* ws; };
typedef const __attribute__((address_space(4))) Params CParams;
__device__ __forceinline__ CParams* kargs() { CParams* q = (CParams*)__builtin_amdgcn_kernarg_segment_ptr(); asm volatile("" : "+s"(q)); return q; }

constexpr size_t al256(size_t x) { return (x + 255) & ~(size_t)255; }
constexpr size_t WS_BAR  = 0;
constexpr size_t WS_MOD  = 16384;
constexpr size_t WS_ROPE = WS_MOD + al256((size_t)4 * 9 * 6144 * 4);
constexpr size_t WS_DFTM = WS_ROPE + al256((size_t)2 * 2048 * 4);
constexpr size_t WS_DFTC = WS_DFTM + (size_t)2048 * 4096 * 2;
constexpr size_t WS_WF   = WS_DFTC + (size_t)256 * 512 * 2;
constexpr size_t WS_WP   = WS_WF + (size_t)4 * 512 * 1024 * 2;
constexpr size_t WS_WO   = WS_WP + (size_t)4 * 1280 * 1024 * 2;
constexpr size_t WS_WGU  = WS_WO + (size_t)4 * 1024 * 1024 * 2;
constexpr size_t WS_WD   = WS_WGU + (size_t)16 * 2048 * 1024 * 2;
constexpr size_t WS_X    = WS_WD + (size_t)16 * 1024 * 1024 * 2;
constexpr size_t WS_XMID = WS_X + (size_t)NTOK * 1024 * 4;
constexpr size_t WS_HX   = WS_XMID + (size_t)NTOK * 1024 * 4;
constexpr size_t WS_AFF  = WS_HX + (size_t)NTOK * 1024 * 2;
constexpr size_t WS_GATE = WS_AFF + (size_t)(8 * 16 * 2048 + 8 * 16 * 256) * 4;
constexpr size_t WS_IDX  = WS_GATE + al256((size_t)16 * 2304 * 4);
constexpr size_t WS_SLOT = WS_IDX + al256((size_t)16 * 2304 * 4);
constexpr size_t WS_R1   = WS_SLOT + (size_t)NTOK * 16 * 4;
constexpr size_t WS_PX   = WS_R1;
constexpr size_t WS_YT   = WS_PX + (size_t)NTOK * 1280 * 2;
constexpr size_t WS_YTC  = WS_YT + (size_t)8 * 256 * 4096 * 2;
constexpr size_t WS_QR   = WS_YTC + (size_t)8 * 256 * 512 * 2;
constexpr size_t WS_KR   = WS_QR + (size_t)NTOK * 512 * 2;
constexpr size_t WS_VR   = WS_KR + (size_t)8 * 2304 * 256 * 2;
constexpr size_t WS_CAT  = WS_VR + (size_t)8 * 2304 * 256 * 2;
constexpr size_t WS_YF   = WS_CAT + (size_t)NTOK * 1024 * 2;
constexpr size_t WS_YFC  = WS_YF + (size_t)8 * 8 * 256 * 512 * 2;
constexpr size_t WS_R1A_END = WS_YFC + (size_t)8 * 256 * 256 * 2;
constexpr size_t WS_XS   = WS_R1;
constexpr size_t WS_HH   = WS_XS + (size_t)16 * 2304 * 1024 * 2;
constexpr size_t WS_R1B_END = WS_HH + (size_t)16 * 2304 * 1024 * 2;
constexpr size_t WS_END0 = WS_R1A_END > WS_R1B_END ? WS_R1A_END : WS_R1B_END;

constexpr size_t WS_WGU2 = WS_END0;
constexpr size_t WS_WD2  = WS_WGU2 + (size_t)16 * 2048 * 1024 * 2;
constexpr size_t WS_END  = WS_WD2 + (size_t)16 * 1024 * 1024 * 2;
constexpr int CONV_A = 6144, CONV_B = 15360, CONV_C = 21504;
constexpr int CONV_UNUSED_ = 0;

__device__ __forceinline__ int opaque_tid() { int t = threadIdx.x; asm volatile("" : "+v"(t)); return t; }
__device__ __forceinline__ unsigned cvt_pk_bf16(float lo, float hi) { unsigned r; asm volatile("v_cvt_pk_bf16_f32 %0, %1, %2" : "=v"(r) : "v"(lo), "v"(hi)); return r; }
__device__ __forceinline__ float bf2f(bf16_t b) { return __uint_as_float(((unsigned)b) << 16); }
__device__ __forceinline__ bf16_t f2bf(float f) { return (bf16_t)(cvt_pk_bf16(f, 0.f) & 0xffffu); }
__device__ __forceinline__ float wave_sum(float v) {
#pragma unroll
  for (int o = 1; o < 64; o <<= 1) v += __shfl_xor(v, o);
  return v;
}
#define LDS_WAIT() asm volatile("s_waitcnt lgkmcnt(0)" ::: "memory")
__device__ __forceinline__ f32x4 ld4bf(const bf16_t* p) { const u32x2 w = *(const u32x2*)p; return (f32x4){__uint_as_float(w.x << 16), __uint_as_float(w.x & 0xffff0000u), __uint_as_float(w.y << 16), __uint_as_float(w.y & 0xffff0000u)}; }
__device__ __forceinline__ void st4bf(bf16_t* p, const f32x4 v) { u32x2 w; w.x = cvt_pk_bf16(v[0], v[1]); w.y = cvt_pk_bf16(v[2], v[3]); *(u32x2*)p = w; }


#define XB_TMO      128
#define XB_XCNT(j)  (256  + 64 * (j))
#define XB_XSUB(j)  (1280 + 64 * (j))
#define XB_XGEN(j)  (2304 + 64 * (j))
#define XB_TOP      3328
#define XB_TOPGEN   3392
#define XCD_BAR_WORDS 3456
#define XB_SPIN_CAP (1u << 18)
__device__ __forceinline__ unsigned xb_ld(unsigned* p)              { return __hip_atomic_load(p, __ATOMIC_RELAXED, __HIP_MEMORY_SCOPE_AGENT); }
__device__ __forceinline__ unsigned xb_add(unsigned* p, unsigned v) { return __hip_atomic_fetch_add(p, v, __ATOMIC_RELAXED, __HIP_MEMORY_SCOPE_AGENT); }
__device__ __forceinline__ unsigned xb_xcc_id() { return (unsigned)__builtin_amdgcn_s_getreg((3 << 11) | 20) & 0xFu; }
#define XB_SPIN(cond, bar) do { unsigned _sp = 0; while (cond) { __builtin_amdgcn_s_sleep(1); \
    if ((++_sp & 255u) == 0u) { if (xb_ld(&(bar)[XB_TMO])) break; if (_sp > XB_SPIN_CAP) { atomicAdd(&(bar)[XB_TMO], 1u); break; } } } } while (0)
__device__ __forceinline__ void xcd_barrier_post(unsigned* bar) { if (threadIdx.x == 0) (void)xb_add(&bar[XB_XCNT(xb_xcc_id())], 1u); }
__device__ __forceinline__ void xcd_barrier_complete(unsigned* bar, unsigned x, unsigned& nloc, unsigned& nx) {
    const unsigned G = gridDim.x * gridDim.y * gridDim.z;
    unsigned sum, cnt, mine, sp = 0u;
    for (;;) {
        sum = 0u; cnt = 0u; mine = 0u;
#pragma unroll
        for (unsigned j = 0; j < 16; ++j) { const unsigned c = xb_ld(&bar[XB_XCNT(j)]); sum += c; cnt += (c > 0u) ? 1u : 0u; mine = (j == x) ? c : mine; }
        if (sum == G) break;
        __builtin_amdgcn_s_sleep(1);
        if ((++sp & 255u) == 0u) { if (xb_ld(&bar[XB_TMO])) break; if (sp > XB_SPIN_CAP) { atomicAdd(&bar[XB_TMO], 1u); break; } }
    }
    nloc = mine > 0u ? mine : 1u; nx = cnt > 0u ? cnt : 1u;
}
__device__ __forceinline__ void xcd_barrier(volatile LAS unsigned* st) {
    asm volatile("s_waitcnt vmcnt(0)" ::: "memory");
    __syncthreads();
    if (threadIdx.x == 0) {
        unsigned* bar = (unsigned*)(kargs()->ws + WS_BAR); const unsigned x = xb_xcc_id();
        __builtin_amdgcn_s_waitcnt(0);
        unsigned nloc = st[0], nx = st[1];
        if (nloc == 0u) { xcd_barrier_complete(bar, x, nloc, nx); st[0] = nloc; st[1] = nx; }
        const unsigned old = xb_add(&bar[XB_XSUB(x)], 1u);
        const unsigned gen = old / nloc;
        if (old == gen * nloc && nloc > 1u) {
            __builtin_amdgcn_fence(__ATOMIC_RELEASE, "agent"); asm volatile("s_waitcnt vmcnt(0)" ::: "memory"); }
        if (old + 1u == (gen + 1u) * nloc) {
            __builtin_amdgcn_fence(__ATOMIC_RELEASE, "agent");
            asm volatile("s_waitcnt vmcnt(0)" ::: "memory");
            const unsigned og = xb_add(&bar[XB_TOP], 1u);
            const unsigned tg = og / nx;
            if (og + 1u == (tg + 1u) * nx) xb_add(&bar[XB_TOPGEN], 1u);
            else XB_SPIN(xb_ld(&bar[XB_TOPGEN]) == tg, bar);
            __builtin_amdgcn_fence(__ATOMIC_ACQUIRE, "agent");
            xb_add(&bar[XB_XGEN(x)], 1u);
            asm volatile("s_waitcnt vmcnt(0)" ::: "memory");
        } else {
            XB_SPIN(xb_ld(&bar[XB_XGEN(x)]) == gen, bar);
            __builtin_amdgcn_fence(__ATOMIC_ACQUIRE, "agent");
            asm volatile("s_waitcnt vmcnt(0)" ::: "memory");
        }
    }
    __syncthreads();
}

namespace pg8 {
constexpr int BM = 256, BK = 64, HALF = 128, HTB = HALF * BK * 2, STAGE_BYTES = 8 * HTB;
__device__ __forceinline__ int lds_byte(int r, int c) { const int st = (r >> 4) * 2 + (c >> 5), rr = r & 15, cc = c & 31, ob = rr * 64 + cc * 2; return st * 1024 + (ob ^ (((ob >> 9) & 1) << 5)); }
__device__ __forceinline__ void stage_rc(int b, int& R, int& C) { const int st = b / 1024, sb = b % 1024, swz = sb ^ (((sb >> 9) & 1) << 5); R = (st >> 1) * 16 + swz / 64; C = (st & 1) * 32 + (swz % 64) / 2; }
__device__ __forceinline__ int perm32(int rho) { const int n = rho >> 4, i = rho & 15; return 8 * (i >> 2) + 4 * n + (i & 3); }

struct Unit { int pm, pn; };
struct Gemm { const bf16_t* A; const bf16_t* Bt; int lda, ldb, K; };

struct Sched {
  int gm, gn, total, G, c, gs;
  __device__ __forceinline__ bool next(int i, Unit& u) const {
    const long L = (long)i * G + c; if (L >= total) return false;
    const int per = gm * gn, g = (int)L / per, r = (int)L % per;
    u.pm = g * gs + r / gn; u.pn = g * gn + r % gn; return true;
  }
};

template <class Epi>
__device__ __forceinline__ void gemm_phase(LAS unsigned char* lds, const Gemm g, const Sched& S, const Epi& E) {
  const int tid = opaque_tid(), wid = __builtin_amdgcn_readfirstlane(tid >> 6), lane = tid & 63, wr = wid >> 2, wc = wid & 3, fr = lane & 15, fq = lane >> 4;
  const int K = g.K, nt = K / BK;
  unsigned voffA[2], voffB[2];
#pragma unroll
  for (int i = 0; i < 2; ++i) { int R, C; stage_rc(tid * 16 + i * 8192, R, C); const int Rb = Epi::PERM ? ((R & ~31) + perm32(R & 31)) : R;
    voffA[i] = (unsigned)(R * g.lda + C) * 2u; voffB[i] = (unsigned)(Rb * g.ldb + C) * 2u; }
  const size_t kstep = (size_t)(BK * 2);
  const size_t hstepA = (size_t)HALF * g.lda * 2, hstepB = (size_t)HALF * g.ldb * 2;
  const size_t tstepA = 2 * hstepA, tstepB = 2 * hstepB;
  const unsigned ldsw = (unsigned)wid * 1024u;
  const int aoff = lds_byte(wr * 64 + fr, fq * 8), boff = lds_byte(wc * 32 + fr, fq * 8);
#define PG8_SA(b, h) (((b) * 2 + (h)) * HTB)
#define PG8_SB(b, h) ((4 + (b) * 2 + (h)) * HTB)
#define PG8_STAGE(bufoff, gbase, voff) do { _Pragma("unroll") for (int _i = 0; _i < 2; ++_i) \
    __builtin_amdgcn_global_load_lds((const unsigned*)((const char*)(gbase) + (voff)[_i]), (LAS unsigned*)(lds + (bufoff) + ldsw + _i * 8192), 16, 0, 0); } while (0)
#define PG8_LDA(dst, b, h) do { _Pragma("unroll") for (int m = 0; m < 4; ++m) _Pragma("unroll") for (int k = 0; k < 2; ++k) dst[m][k] = *(const LAS bf16x8*)(lds + PG8_SA(b, h) + aoff + m * 2048 + k * 1024); } while (0)
#define PG8_LDB(dst, b, h) do { _Pragma("unroll") for (int n = 0; n < 2; ++n) _Pragma("unroll") for (int k = 0; k < 2; ++k) dst[n][k] = *(const LAS bf16x8*)(lds + PG8_SB(b, h) + boff + n * 2048 + k * 1024); } while (0)
#define PG8_MMA(ai, bj, At, Bt) do { __builtin_amdgcn_s_setprio(1); _Pragma("unroll") for (int m = 0; m < 4; ++m) _Pragma("unroll") for (int n = 0; n < 2; ++n) _Pragma("unroll") for (int k = 0; k < 2; ++k) \
    acc[ai][bj][m][n] = __builtin_amdgcn_mfma_f32_16x16x32_bf16(Bt[n][k], At[m][k], acc[ai][bj][m][n], 0, 0, 0); __builtin_amdgcn_s_setprio(0); } while (0)
#define PG8_WAIT_V(n) asm volatile("s_waitcnt vmcnt(" #n ")" ::: "memory")
#define PG8_WAIT_L(n) asm volatile("s_waitcnt lgkmcnt(" #n ")" ::: "memory")
#define PG8_BAR __builtin_amdgcn_s_barrier()
#define PG8_SCHED __builtin_amdgcn_sched_barrier(0)
  Unit cur, nxt; int ui = 0;
  if (!S.next(0, cur)) return;
  f32x4 acc[2][2][4][2];
#pragma unroll
  for (int a = 0; a < 2; ++a)
#pragma unroll
    for (int b = 0; b < 2; ++b)
#pragma unroll
      for (int m = 0; m < 4; ++m)
#pragma unroll
        for (int n = 0; n < 2; ++n) acc[a][b][m][n] = (f32x4){0.f, 0.f, 0.f, 0.f};
  bf16x8 At[4][2], B0[2][2], B1[2][2];
  const char* cA = (const char*)g.A + (size_t)cur.pm * tstepA; const char* cB = (const char*)g.Bt + (size_t)cur.pn * tstepB;
  PG8_STAGE(PG8_SB(0, 0), cB, voffB); PG8_STAGE(PG8_SA(0, 0), cA, voffA); PG8_STAGE(PG8_SB(0, 1), cB + hstepB, voffB); PG8_STAGE(PG8_SA(0, 1), cA + hstepA, voffA);
  if (wr == 1) PG8_BAR;
  PG8_WAIT_V(4); PG8_BAR;
  PG8_STAGE(PG8_SB(1, 0), cB + kstep, voffB); PG8_STAGE(PG8_SA(1, 0), cA + kstep, voffA); PG8_STAGE(PG8_SB(1, 1), cB + hstepB + kstep, voffB);
  PG8_WAIT_V(6); PG8_BAR;
  for (;;) {
    const bool has_next = S.next(ui + 1, nxt);
    const char* nA = has_next ? (const char*)g.A + (size_t)nxt.pm * tstepA : cA; const char* nB = has_next ? (const char*)g.Bt + (size_t)nxt.pn * tstepB : cB;
    for (int t = 0; t < nt; t += 2) {
      const bool last = (t == nt - 2);
      const char* a1 = cA + (size_t)(t + 1) * kstep;
      const char* a2 = last ? nA : cA + (size_t)(t + 2) * kstep; const char* b2 = last ? nB : cB + (size_t)(t + 2) * kstep;
      const char* a3 = a2 + kstep; const char* b3 = b2 + kstep;
      PG8_LDB(B0, 0, 0); PG8_SCHED; PG8_LDA(At, 0, 0); PG8_STAGE(PG8_SA(1, 1), a1 + hstepA, voffA);
      PG8_WAIT_L(8); PG8_BAR; PG8_WAIT_L(0); PG8_MMA(0, 0, At, B0); PG8_BAR; PG8_SCHED;
      PG8_LDB(B1, 0, 1); PG8_STAGE(PG8_SB(0, 0), b2, voffB);
      PG8_BAR; PG8_WAIT_L(0); PG8_MMA(0, 1, At, B1); PG8_BAR;
      PG8_LDA(At, 0, 1); PG8_STAGE(PG8_SA(0, 0), a2, voffA);
      PG8_BAR; PG8_WAIT_L(0); PG8_MMA(1, 0, At, B0); PG8_BAR; PG8_SCHED;
      PG8_STAGE(PG8_SB(0, 1), b2 + hstepB, voffB);
      PG8_WAIT_V(6); PG8_BAR; PG8_MMA(1, 1, At, B1); PG8_BAR;
      PG8_LDB(B0, 1, 0); PG8_SCHED; PG8_LDA(At, 1, 0); PG8_STAGE(PG8_SA(0, 1), a2 + hstepA, voffA);
      PG8_WAIT_L(8); PG8_BAR; PG8_WAIT_L(0); PG8_MMA(0, 0, At, B0); PG8_BAR; PG8_SCHED;
      PG8_LDB(B1, 1, 1); PG8_STAGE(PG8_SB(1, 0), b3, voffB);
      PG8_BAR; PG8_WAIT_L(0); PG8_MMA(0, 1, At, B1); PG8_BAR;
      PG8_LDA(At, 1, 1); PG8_STAGE(PG8_SA(1, 0), a3, voffA);
      PG8_BAR; PG8_WAIT_L(0); PG8_MMA(1, 0, At, B0); PG8_BAR; PG8_SCHED;
      PG8_STAGE(PG8_SB(1, 1), b3 + hstepB, voffB);
      PG8_WAIT_V(6); PG8_BAR; PG8_MMA(1, 1, At, B1); PG8_BAR;
    }
    E(acc, cur, wr, wc, fr, fq);
#if defined(DUP_MASK)
    if (DUP_MASK & 8192) E(acc, cur, wr, wc, fr, fq);
#endif
    if (!has_next) break;
#pragma unroll
    for (int a = 0; a < 2; ++a)
#pragma unroll
      for (int b = 0; b < 2; ++b)
#pragma unroll
        for (int m = 0; m < 4; ++m)
#pragma unroll
          for (int n = 0; n < 2; ++n) acc[a][b][m][n] = (f32x4){0.f, 0.f, 0.f, 0.f};
    cur = nxt; cA = nA; cB = nB; ++ui;
  }
  PG8_WAIT_V(0);
  if (wr == 0) PG8_BAR;
  PG8_BAR;
#undef PG8_SA
#undef PG8_SB
#undef PG8_STAGE
#undef PG8_LDA
#undef PG8_LDB
#undef PG8_MMA
#undef PG8_WAIT_V
#undef PG8_WAIT_L
#undef PG8_BAR
#undef PG8_SCHED
}

template <class Epi>
__device__ __forceinline__ void gemm_phase_gather(LAS unsigned char* lds, const Gemm g, const int* __restrict__ rowidx, const Sched& S, const Epi& E) {
  const int tid = opaque_tid(), wid = __builtin_amdgcn_readfirstlane(tid >> 6), lane = tid & 63, wr = wid >> 2, wc = wid & 3, fr = lane & 15, fq = lane >> 4;
  const int K = g.K, nt = K / BK;
  unsigned voffB[2]; int Rr[2], Cc[2];
#pragma unroll
  for (int i = 0; i < 2; ++i) { int R, C; stage_rc(tid * 16 + i * 8192, R, C); const int Rb = Epi::PERM ? ((R & ~31) + perm32(R & 31)) : R;
    Rr[i] = R; Cc[i] = C; voffB[i] = (unsigned)(Rb * g.ldb + C) * 2u; }
  unsigned vc0[2], vc1[2], vn0[2], vn1[2];
#define PG8_ROWOFF(v0, v1, u) do { _Pragma("unroll") for (int _i = 0; _i < 2; ++_i) { \
    v0[_i] = (unsigned)(rowidx[(u).pm * 256 + Rr[_i]] * g.lda + Cc[_i]) * 2u; v1[_i] = (unsigned)(rowidx[(u).pm * 256 + 128 + Rr[_i]] * g.lda + Cc[_i]) * 2u; } } while (0)
  const size_t kstep = (size_t)(BK * 2);
  const size_t hstepB = (size_t)HALF * g.ldb * 2;
  const size_t tstepB = 2 * hstepB;
  const unsigned ldsw = (unsigned)wid * 1024u;
  const int aoff = lds_byte(wr * 64 + fr, fq * 8), boff = lds_byte(wc * 32 + fr, fq * 8);
#define PG8_SA(b, h) (((b) * 2 + (h)) * HTB)
#define PG8_SB(b, h) ((4 + (b) * 2 + (h)) * HTB)
#define PG8_STAGE(bufoff, gbase, voff) do { _Pragma("unroll") for (int _i = 0; _i < 2; ++_i) \
    __builtin_amdgcn_global_load_lds((const unsigned*)((const char*)(gbase) + (voff)[_i]), (LAS unsigned*)(lds + (bufoff) + ldsw + _i * 8192), 16, 0, 0); } while (0)
#define PG8_LDA(dst, b, h) do { _Pragma("unroll") for (int m = 0; m < 4; ++m) _Pragma("unroll") for (int k = 0; k < 2; ++k) dst[m][k] = *(const LAS bf16x8*)(lds + PG8_SA(b, h) + aoff + m * 2048 + k * 1024); } while (0)
#define PG8_LDB(dst, b, h) do { _Pragma("unroll") for (int n = 0; n < 2; ++n) _Pragma("unroll") for (int k = 0; k < 2; ++k) dst[n][k] = *(const LAS bf16x8*)(lds + PG8_SB(b, h) + boff + n * 2048 + k * 1024); } while (0)
#define PG8_MMA(ai, bj, At, Bt) do { __builtin_amdgcn_s_setprio(1); _Pragma("unroll") for (int m = 0; m < 4; ++m) _Pragma("unroll") for (int n = 0; n < 2; ++n) _Pragma("unroll") for (int k = 0; k < 2; ++k) \
    acc[ai][bj][m][n] = __builtin_amdgcn_mfma_f32_16x16x32_bf16(Bt[n][k], At[m][k], acc[ai][bj][m][n], 0, 0, 0); __builtin_amdgcn_s_setprio(0); } while (0)
#define PG8_WAIT_V(n) asm volatile("s_waitcnt vmcnt(" #n ")" ::: "memory")
#define PG8_WAIT_L(n) asm volatile("s_waitcnt lgkmcnt(" #n ")" ::: "memory")
#define PG8_BAR __builtin_amdgcn_s_barrier()
#define PG8_SCHED __builtin_amdgcn_sched_barrier(0)
  Unit cur, nxt; int ui = 0;
  if (!S.next(0, cur)) return;
  f32x4 acc[2][2][4][2];
#pragma unroll
  for (int a = 0; a < 2; ++a)
#pragma unroll
    for (int b = 0; b < 2; ++b)
#pragma unroll
      for (int m = 0; m < 4; ++m)
#pragma unroll
        for (int n = 0; n < 2; ++n) acc[a][b][m][n] = (f32x4){0.f, 0.f, 0.f, 0.f};
  bf16x8 At[4][2], B0[2][2], B1[2][2];
  const char* cA = (const char*)g.A; const char* cB = (const char*)g.Bt + (size_t)cur.pn * tstepB;
  PG8_ROWOFF(vc0, vc1, cur);
  PG8_STAGE(PG8_SB(0, 0), cB, voffB); PG8_STAGE(PG8_SA(0, 0), cA, vc0); PG8_STAGE(PG8_SB(0, 1), cB + hstepB, voffB); PG8_STAGE(PG8_SA(0, 1), cA, vc1);
  if (wr == 1) PG8_BAR;
  PG8_WAIT_V(4); PG8_BAR;
  PG8_STAGE(PG8_SB(1, 0), cB + kstep, voffB); PG8_STAGE(PG8_SA(1, 0), cA + kstep, vc0); PG8_STAGE(PG8_SB(1, 1), cB + hstepB + kstep, voffB);
  PG8_WAIT_V(6); PG8_BAR;
  for (;;) {
    const bool has_next = S.next(ui + 1, nxt);
    const char* nB = has_next ? (const char*)g.Bt + (size_t)nxt.pn * tstepB : cB;
    if (has_next) PG8_ROWOFF(vn0, vn1, nxt); else { vn0[0] = vc0[0]; vn0[1] = vc0[1]; vn1[0] = vc1[0]; vn1[1] = vc1[1]; }
    for (int t = 0; t < nt; t += 2) {
      const bool last = (t == nt - 2);
      const char* a1 = cA + (size_t)(t + 1) * kstep;
      const char* a2 = last ? cA : cA + (size_t)(t + 2) * kstep; const char* b2 = last ? nB : cB + (size_t)(t + 2) * kstep;
      unsigned s0[2], s1[2]; s0[0] = last ? vn0[0] : vc0[0]; s0[1] = last ? vn0[1] : vc0[1]; s1[0] = last ? vn1[0] : vc1[0]; s1[1] = last ? vn1[1] : vc1[1];
      const char* a3 = a2 + kstep; const char* b3 = b2 + kstep;
      PG8_LDB(B0, 0, 0); PG8_SCHED; PG8_LDA(At, 0, 0); PG8_STAGE(PG8_SA(1, 1), a1, vc1);
      PG8_WAIT_L(8); PG8_BAR; PG8_WAIT_L(0); PG8_MMA(0, 0, At, B0); PG8_BAR; PG8_SCHED;
      PG8_LDB(B1, 0, 1); PG8_STAGE(PG8_SB(0, 0), b2, voffB);
      PG8_BAR; PG8_WAIT_L(0); PG8_MMA(0, 1, At, B1); PG8_BAR;
      PG8_LDA(At, 0, 1); PG8_STAGE(PG8_SA(0, 0), a2, s0);
      PG8_BAR; PG8_WAIT_L(0); PG8_MMA(1, 0, At, B0); PG8_BAR; PG8_SCHED;
      PG8_STAGE(PG8_SB(0, 1), b2 + hstepB, voffB);
      PG8_WAIT_V(6); PG8_BAR; PG8_MMA(1, 1, At, B1); PG8_BAR;
      PG8_LDB(B0, 1, 0); PG8_SCHED; PG8_LDA(At, 1, 0); PG8_STAGE(PG8_SA(0, 1), a2, s1);
      PG8_WAIT_L(8); PG8_BAR; PG8_WAIT_L(0); PG8_MMA(0, 0, At, B0); PG8_BAR; PG8_SCHED;
      PG8_LDB(B1, 1, 1); PG8_STAGE(PG8_SB(1, 0), b3, voffB);
      PG8_BAR; PG8_WAIT_L(0); PG8_MMA(0, 1, At, B1); PG8_BAR;
      PG8_LDA(At, 1, 1); PG8_STAGE(PG8_SA(1, 0), a3, s0);
      PG8_BAR; PG8_WAIT_L(0); PG8_MMA(1, 0, At, B0); PG8_BAR; PG8_SCHED;
      PG8_STAGE(PG8_SB(1, 1), b3 + hstepB, voffB);
      PG8_WAIT_V(6); PG8_BAR; PG8_MMA(1, 1, At, B1); PG8_BAR;
    }
    E(acc, cur, wr, wc, fr, fq);
#if defined(DUP_MASK)
    if (DUP_MASK & 8192) E(acc, cur, wr, wc, fr, fq);
#endif
    if (!has_next) break;
#pragma unroll
    for (int a = 0; a < 2; ++a)
#pragma unroll
      for (int b = 0; b < 2; ++b)
#pragma unroll
        for (int m = 0; m < 4; ++m)
#pragma unroll
          for (int n = 0; n < 2; ++n) acc[a][b][m][n] = (f32x4){0.f, 0.f, 0.f, 0.f};
    cur = nxt; cB = nB; ++ui; vc0[0] = vn0[0]; vc0[1] = vn0[1]; vc1[0] = vn1[0]; vc1[1] = vn1[1];
  }
  PG8_WAIT_V(0);
  if (wr == 0) PG8_BAR;
  PG8_BAR;
#undef PG8_ROWOFF
#undef PG8_SA
#undef PG8_SB
#undef PG8_STAGE
#undef PG8_LDA
#undef PG8_LDB
#undef PG8_MMA
#undef PG8_WAIT_V
#undef PG8_WAIT_L
#undef PG8_BAR
#undef PG8_SCHED
}

struct EpiBf16 {
  static constexpr bool PERM = true;
  bf16_t* O; int ldc;
  __device__ __forceinline__ void operator()(const f32x4 (&acc)[2][2][4][2], const Unit& u, int wr, int wc, int fr, int fq) const {
    const int row0 = u.pm * BM + wr * 64 + fr, col0 = u.pn * BM + wc * 32 + 8 * fq;
#pragma unroll
    for (int ai = 0; ai < 2; ++ai)
#pragma unroll
      for (int m = 0; m < 4; ++m) { bf16_t* rowp = O + (size_t)(row0 + ai * HALF + m * 16) * ldc + col0;
#pragma unroll
        for (int bj = 0; bj < 2; ++bj) { const f32x4 v0 = acc[ai][bj][m][0], v1 = acc[ai][bj][m][1];
          u32x4 w; w.x = cvt_pk_bf16(v0[0], v0[1]); w.y = cvt_pk_bf16(v0[2], v0[3]); w.z = cvt_pk_bf16(v1[0], v1[1]); w.w = cvt_pk_bf16(v1[2], v1[3]);
          *(u32x4*)(rowp + bj * HALF) = w; } }
  }
};
struct EpiYT {
  static constexpr bool PERM = true;
  bf16_t* YT; bf16_t* YTC;
  __device__ __forceinline__ void operator()(const f32x4 (&acc)[2][2][4][2], const Unit& u, int wr, int wc, int fr, int fq) const {
    const bool lat = u.pn < 64;
    const int b = lat ? (u.pn >> 3) : (u.pn - 64);
    const int tb = (lat ? (u.pn & 7) * 256 : 0) + wc * 32 + 8 * fq;
    const int nseq = lat ? 2048 : 256;
    bf16_t* base = lat ? YT : YTC;
#pragma unroll
    for (int ai = 0; ai < 2; ++ai)
#pragma unroll
      for (int m = 0; m < 4; ++m) { const int hl = ai * HALF + wr * 64 + m * 16 + fr;
        bf16_t* rowp = base + (size_t)(b * 256 + hl) * nseq + tb;
#pragma unroll
        for (int bj = 0; bj < 2; ++bj) { const f32x4 v0 = acc[ai][bj][m][0], v1 = acc[ai][bj][m][1];
          u32x4 w; w.x = cvt_pk_bf16(v0[0], v0[1]); w.y = cvt_pk_bf16(v0[2], v0[3]); w.z = cvt_pk_bf16(v1[0], v1[1]); w.w = cvt_pk_bf16(v1[2], v1[3]);
          *(u32x4*)(rowp + bj * HALF) = w; } }
  }
};
struct EpiDft {
  static constexpr bool PERM = true;
  bf16_t* CAT; int tok0, nseq; float scale;
  __device__ __forceinline__ void operator()(const f32x4 (&acc)[2][2][4][2], const Unit& u, int wr, int wc, int fr, int fq) const {
    const int row0 = tok0 + u.pn * nseq + u.pm * BM + wr * 64 + fr, col0 = wc * 32 + 8 * fq;
#pragma unroll
    for (int ai = 0; ai < 2; ++ai)
#pragma unroll
      for (int m = 0; m < 4; ++m) { bf16_t* rowp = CAT + (size_t)(row0 + ai * HALF + m * 16) * 1024 + col0;
#pragma unroll
        for (int bj = 0; bj < 2; ++bj) { const f32x4 v0 = acc[ai][bj][m][0] * scale, v1 = acc[ai][bj][m][1] * scale;
          u32x4 w; w.x = cvt_pk_bf16(v0[0], v0[1]); w.y = cvt_pk_bf16(v0[2], v0[3]); w.z = cvt_pk_bf16(v1[0], v1[1]); w.w = cvt_pk_bf16(v1[2], v1[3]);
          *(u32x4*)(rowp + bj * HALF) = w; } }
  }
};
struct EpiDft2 {
  static constexpr bool PERM = true;
  bf16_t* CAT; float scale;
  __device__ __forceinline__ void operator()(const f32x4 (&acc)[2][2][4][2], const Unit& u, int wr, int wc, int fr, int fq) const {
    const int rowb = (u.pn >> 3) * SEQ + (u.pn & 7), k20 = wr * 64 + fr, col0 = wc * 32 + 8 * fq;
#pragma unroll
    for (int ai = 0; ai < 2; ++ai)
#pragma unroll
      for (int m = 0; m < 4; ++m) { bf16_t* rowp = CAT + (size_t)(rowb + 8 * (k20 + ai * HALF + m * 16)) * 1024 + col0;
#pragma unroll
        for (int bj = 0; bj < 2; ++bj) { const f32x4 v0 = acc[ai][bj][m][0] * scale, v1 = acc[ai][bj][m][1] * scale;
          u32x4 w; w.x = cvt_pk_bf16(v0[0], v0[1]); w.y = cvt_pk_bf16(v0[2], v0[3]); w.z = cvt_pk_bf16(v1[0], v1[1]); w.w = cvt_pk_bf16(v1[2], v1[3]);
          *(u32x4*)(rowp + bj * HALF) = w; } }
  }
};
struct EpiOut {
  static constexpr bool PERM = true;
  const bf16_t* X; bf16_t* XMID; const float* modl;
  __device__ __forceinline__ void operator()(const f32x4 (&acc)[2][2][4][2], const Unit& u, int wr, int wc, int fr, int fq) const {
    const int row0 = u.pm * BM + wr * 64 + fr, col0 = u.pn * BM + wc * 32 + 8 * fq;
    const int s = u.pm < 64 ? (u.pm >> 3) : 8;
    const float* g1 = modl + (size_t)s * 6144 + 2048 + col0;
    f32x4 gv[2][2];
#pragma unroll
    for (int bj = 0; bj < 2; ++bj)
#pragma unroll
      for (int n = 0; n < 2; ++n) gv[bj][n] = *(const f32x4*)(g1 + bj * HALF + n * 4);
#pragma unroll
    for (int ai = 0; ai < 2; ++ai)
#pragma unroll
      for (int m = 0; m < 4; ++m) { const size_t off = (size_t)(row0 + ai * HALF + m * 16) * 1024 + col0;
#pragma unroll
        for (int bj = 0; bj < 2; ++bj) { const u32x4 xw = *(const u32x4*)(X + off + bj * HALF);
          const f32x4 x0 = (f32x4){__uint_as_float(xw.x << 16), __uint_as_float(xw.x & 0xffff0000u), __uint_as_float(xw.y << 16), __uint_as_float(xw.y & 0xffff0000u)};
          const f32x4 x1 = (f32x4){__uint_as_float(xw.z << 16), __uint_as_float(xw.z & 0xffff0000u), __uint_as_float(xw.w << 16), __uint_as_float(xw.w & 0xffff0000u)};
          const f32x4 v0 = x0 + gv[bj][0] * acc[ai][bj][m][0], v1 = x1 + gv[bj][1] * acc[ai][bj][m][1];
          u32x4 w; w.x = cvt_pk_bf16(v0[0], v0[1]); w.y = cvt_pk_bf16(v0[2], v0[3]); w.z = cvt_pk_bf16(v1[0], v1[1]); w.w = cvt_pk_bf16(v1[2], v1[3]);
          *(u32x4*)(XMID + off + bj * HALF) = w; }
        asm volatile("" ::: "memory"); }
  }
};
struct EpiMoe1 {
  static constexpr bool PERM = true;
  bf16_t* HH;
  __device__ __forceinline__ void operator()(const f32x4 (&acc)[2][2][4][2], const Unit& u, int wr, int wc, int fr, int fq) const {
    const int row0 = u.pm * BM + wr * 64 + fr, col0 = (u.pn & 7) * 128 + wc * 32 + 8 * fq;
#pragma unroll
    for (int ai = 0; ai < 2; ++ai)
#pragma unroll
      for (int m = 0; m < 4; ++m) { bf16_t* rowp = HH + (size_t)(row0 + ai * HALF + m * 16) * 1024 + col0;
        float h[8];
#pragma unroll
        for (int n = 0; n < 2; ++n)
#pragma unroll
          for (int j = 0; j < 4; ++j) { const float a = acc[ai][0][m][n][j], uu = acc[ai][1][m][n][j];
            h[n * 4 + j] = a * __builtin_amdgcn_rcpf(1.f + __expf(-a)) * uu; }
        u32x4 w; w.x = cvt_pk_bf16(h[0], h[1]); w.y = cvt_pk_bf16(h[2], h[3]); w.z = cvt_pk_bf16(h[4], h[5]); w.w = cvt_pk_bf16(h[6], h[7]);
        *(u32x4*)rowp = w; }
  }
};
struct EpiMoe2 {
  static constexpr bool PERM = true;
  bf16_t* YY; const float* gate;
  __device__ __forceinline__ void operator()(const f32x4 (&acc)[2][2][4][2], const Unit& u, int wr, int wc, int fr, int fq) const {
    const int row0 = u.pm * BM + wr * 64 + fr, col0 = (u.pn & 3) * BM + wc * 32 + 8 * fq;
#pragma unroll
    for (int ai = 0; ai < 2; ++ai)
#pragma unroll
      for (int m = 0; m < 4; ++m) { const int row = row0 + ai * HALF + m * 16; const float gt = gate[row];
        bf16_t* rowp = YY + (size_t)row * 1024 + col0;
#pragma unroll
        for (int bj = 0; bj < 2; ++bj) { const f32x4 v0 = acc[ai][bj][m][0] * gt, v1 = acc[ai][bj][m][1] * gt;
          u32x4 w; w.x = cvt_pk_bf16(v0[0], v0[1]); w.y = cvt_pk_bf16(v0[2], v0[3]); w.z = cvt_pk_bf16(v1[0], v1[1]); w.w = cvt_pk_bf16(v1[2], v1[3]);
          *(u32x4*)(rowp + bj * HALF) = w; } }
  }
};
}

namespace att {
constexpr int D = 128, QBLK = 32, KVBLK = 64;
constexpr float SCALE = 0.088388347648318440f;
constexpr float THR = 8.f;
constexpr int LDQ = 1280, LDK = 256, LDO = 1024;
constexpr size_t SHM_V = KVBLK * D * 2, SHM_K = KVBLK * D * 2, SHM_ATTN = 2 * SHM_V + 2 * SHM_K + 8 * 64 * 4;
#define KSWZ(row, colB) ((row) * 256 + ((colB) ^ (((row) & 7) << 4)))
#define SBAR() __builtin_amdgcn_sched_barrier(0)
__device__ __forceinline__ int crow(int r, int hi) { return (r & 3) + 8 * (r >> 2) + 4 * hi; }
__device__ __forceinline__ void partialSM(f32x16& p0, f32x16& p1, float& m_reg, float& mn, float& alpha) {
  constexpr float C = SCALE * 1.4426950408889634f;
  float pmax = p0[0];
#pragma unroll
  for (int r = 1; r < 16; ++r) pmax = fmaxf(pmax, p0[r]);
#pragma unroll
  for (int r = 0; r < 16; ++r) pmax = fmaxf(pmax, p1[r]);
  { auto rr = __builtin_amdgcn_permlane32_swap(__float_as_uint(pmax), __float_as_uint(pmax), false, false);
    pmax = fmaxf(__uint_as_float(rr[0]), __uint_as_float(rr[1])); }
  if (__builtin_expect(__all(pmax - m_reg <= THR / SCALE), 1)) { mn = m_reg; alpha = 1.f; }
  else { mn = fmaxf(m_reg, pmax); alpha = __builtin_amdgcn_exp2f((m_reg - mn) * C); m_reg = mn; }
  float mnC = -mn * C;
#pragma unroll
  for (int r = 0; r < 16; ++r) p0[r] = fmaf(p0[r], C, mnC);
#pragma unroll
  for (int r = 0; r < 16; ++r) p1[r] = fmaf(p1[r], C, mnC);
#pragma unroll
  for (int r = 0; r < 16; ++r) p0[r] = __builtin_amdgcn_exp2f(p0[r]);
}
__device__ __forceinline__ void finishSM(f32x16& p0, f32x16& p1, float alpha, float& l_reg, bf16x8& pa0, bf16x8& pa1, bf16x8& pa2, bf16x8& pa3) {
#pragma unroll
  for (int r = 0; r < 16; ++r) p1[r] = __builtin_amdgcn_exp2f(p1[r]);
  float ps = 0;
#pragma unroll
  for (int r = 0; r < 16; ++r) ps += p0[r];
#pragma unroll
  for (int r = 0; r < 16; ++r) ps += p1[r];
  { auto rr = __builtin_amdgcn_permlane32_swap(__float_as_uint(ps), __float_as_uint(ps), false, false);
    ps = __uint_as_float(rr[0]) + __uint_as_float(rr[1]); }
  l_reg = l_reg * alpha + ps;
#define PK4(P, BASE, OUT) do { unsigned a0 = cvt_pk_bf16(P[BASE + 0], P[BASE + 1]), a1 = cvt_pk_bf16(P[BASE + 2], P[BASE + 3]);   \
    unsigned b0 = cvt_pk_bf16(P[BASE + 4], P[BASE + 5]), b1 = cvt_pk_bf16(P[BASE + 6], P[BASE + 7]);                              \
    auto r0 = __builtin_amdgcn_permlane32_swap(a0, b0, false, false); auto r1 = __builtin_amdgcn_permlane32_swap(a1, b1, false, false); \
    u32x4 w = {r0[0], r1[0], r0[1], r1[1]}; OUT = *reinterpret_cast<bf16x8*>(&w); } while (0)
  PK4(p0, 0, pa0); PK4(p0, 8, pa1); PK4(p1, 0, pa2); PK4(p1, 8, pa3);
#undef PK4
}
__device__ __forceinline__ void qkt(f32x16& p0, f32x16& p1, const bf16_t* Ks, const bf16x8* qr, int r32, int hi) {
  p0 = f32x16{}; p1 = f32x16{};
#pragma unroll
  for (int d0 = 0; d0 < 8; ++d0) { int cb = (d0 * 16 + hi * 8) * 2;
    bf16x8 b0 = *reinterpret_cast<const bf16x8*>((const char*)Ks + KSWZ(r32, cb));
    bf16x8 b1 = *reinterpret_cast<const bf16x8*>((const char*)Ks + KSWZ(32 + r32, cb));
    p0 = __builtin_amdgcn_mfma_f32_32x32x16_bf16(b0, qr[d0], p0, 0, 0, 0);
    p1 = __builtin_amdgcn_mfma_f32_32x32x16_bf16(b1, qr[d0], p1, 0, 0, 0); }
}
__device__ __forceinline__ int v_st(int k, int c) { const int kk = (k & ~0xC) | ((k & 4) << 1) | ((k & 8) >> 1); return ((kk >> 3) * 4 + (c >> 5)) * 512 + ((kk & 7) * 32 + (c & 31)) * 2; }
__device__ __forceinline__ int v_rd_base(int lane) { return ((lane & 3) << 3) | (((lane >> 2) & 3) << 6) | (((lane >> 4) & 1) << 5) | (((lane >> 5) & 1) << 8); }
constexpr int v_rd_off(int d0, int ks, int half) { return d0 * 512 + ks * 4096 + half * 2048; }
template <int OFF> __device__ __forceinline__ s16x4 tr_read(int vb) {
  s16x4 r; asm volatile("ds_read_b64_tr_b16 %0, %1 offset:%2" : "=&v"(r) : "v"(vb), "i"(OFF) : "memory"); return r;
}
template <int D0> __device__ __forceinline__ void pv_one(f32x16& od, int vb, bf16x8 pa0, bf16x8 pa1, bf16x8 pa2, bf16x8 pa3) {
  const s16x4 l0 = tr_read<v_rd_off(D0, 0, 0)>(vb), h0 = tr_read<v_rd_off(D0, 0, 1)>(vb), l1 = tr_read<v_rd_off(D0, 1, 0)>(vb), h1 = tr_read<v_rd_off(D0, 1, 1)>(vb);
  const s16x4 l2 = tr_read<v_rd_off(D0, 2, 0)>(vb), h2 = tr_read<v_rd_off(D0, 2, 1)>(vb), l3 = tr_read<v_rd_off(D0, 3, 0)>(vb), h3 = tr_read<v_rd_off(D0, 3, 1)>(vb);
  asm volatile("s_waitcnt lgkmcnt(0)" ::: "memory"); SBAR();
#define PK(L, H) (bf16x8){L[0], L[1], L[2], L[3], H[0], H[1], H[2], H[3]}
  od = __builtin_amdgcn_mfma_f32_32x32x16_bf16(pa0, PK(l0, h0), od, 0, 0, 0);
  od = __builtin_amdgcn_mfma_f32_32x32x16_bf16(pa1, PK(l1, h1), od, 0, 0, 0);
  od = __builtin_amdgcn_mfma_f32_32x32x16_bf16(pa2, PK(l2, h2), od, 0, 0, 0);
  od = __builtin_amdgcn_mfma_f32_32x32x16_bf16(pa3, PK(l3, h3), od, 0, 0, 0);
#undef PK
}
__device__ __forceinline__ void pv_d0(f32x16* o, int vb, bf16x8 pa0, bf16x8 pa1, bf16x8 pa2, bf16x8 pa3) {
  pv_one<0>(o[0], vb, pa0, pa1, pa2, pa3); pv_one<1>(o[1], vb, pa0, pa1, pa2, pa3); pv_one<2>(o[2], vb, pa0, pa1, pa2, pa3); pv_one<3>(o[3], vb, pa0, pa1, pa2, pa3);
}
__device__ __forceinline__ void attn_dense_body(const bf16_t* __restrict__ Qb, const bf16_t* __restrict__ Kh, const bf16_t* __restrict__ Vh,
                                                bf16_t* __restrict__ Ob, int seq, char* lds, const float* __restrict__ qg, const float* __restrict__ RC, const float* __restrict__ RS, const bool rope, const int tpos) {
  const int tid = opaque_tid(), wid = tid >> 6, lane = tid & 63, r32 = lane & 31, hi = lane >> 5;
  bf16_t* V_lds = (bf16_t*)lds; bf16_t* K_lds = (bf16_t*)(lds + 2 * SHM_V);
  float* wsl = (float*)(lds + 2 * SHM_V + 2 * SHM_K) + wid * 64; float* li_l = wsl; float* al_l = wsl + 32;
  float m_reg = -1e30f, l_reg = 0; f32x16 o[4] = {}; bf16x8 qr[8];
  const bf16_t* Qw = Qb + (long)(wid * QBLK + r32) * LDQ + hi * 8;
  { float f[8][8]; float ss = 0.f;
#pragma unroll
    for (int d0 = 0; d0 < 8; ++d0) { const u32x4 w = *reinterpret_cast<const u32x4*>(Qw + d0 * 16);
      f[d0][0] = __uint_as_float(w.x << 16); f[d0][1] = __uint_as_float(w.x & 0xffff0000u); f[d0][2] = __uint_as_float(w.y << 16); f[d0][3] = __uint_as_float(w.y & 0xffff0000u);
      f[d0][4] = __uint_as_float(w.z << 16); f[d0][5] = __uint_as_float(w.z & 0xffff0000u); f[d0][6] = __uint_as_float(w.w << 16); f[d0][7] = __uint_as_float(w.w & 0xffff0000u);
#pragma unroll
      for (int j = 0; j < 8; ++j) ss += f[d0][j] * f[d0][j]; }
    ss += __shfl_xor(ss, 32);
    const float rn = rsqrtf(ss * (1.f / 128.f) + EPS);
#pragma unroll
    for (int d0 = 0; d0 < 8; ++d0) { const f32x4 g0 = *(const f32x4*)(qg + d0 * 16 + hi * 8), g1 = *(const f32x4*)(qg + d0 * 16 + hi * 8 + 4);
#pragma unroll
      for (int j = 0; j < 4; ++j) { f[d0][j] *= rn * g0[j]; f[d0][4 + j] *= rn * g1[j]; } }
    if (rope) { const int t = tpos + wid * QBLK + r32;
#pragma unroll
      for (int blk = 0; blk < 2; ++blk) { const int pos = blk ? (t & 63) : (t >> 6);
#pragma unroll
        for (int q = 0; q < 2; ++q) { const int o = pos * 32 + q * 16 + hi * 8;
          const f32x4 c0 = *(const f32x4*)(RC + o), c1 = *(const f32x4*)(RC + o + 4), s0 = *(const f32x4*)(RS + o), s1 = *(const f32x4*)(RS + o + 4);
#pragma unroll
          for (int j = 0; j < 8; ++j) { const float cs = j < 4 ? c0[j & 3] : c1[j & 3], sn = j < 4 ? s0[j & 3] : s1[j & 3];
            const float x1 = f[4 * blk + q][j], x2 = f[4 * blk + q + 2][j]; f[4 * blk + q][j] = x1 * cs - x2 * sn; f[4 * blk + q + 2][j] = x2 * cs + x1 * sn; } } } }
#pragma unroll
    for (int d0 = 0; d0 < 8; ++d0) { u32x4 w; w.x = cvt_pk_bf16(f[d0][0], f[d0][1]); w.y = cvt_pk_bf16(f[d0][2], f[d0][3]); w.z = cvt_pk_bf16(f[d0][4], f[d0][5]); w.w = cvt_pk_bf16(f[d0][6], f[d0][7]);
      qr[d0] = *reinterpret_cast<bf16x8*>(&w); } }
  const int sr = tid >> 4, sc = (tid & 15) * 8, vst0 = v_st(sr, sc), vst1 = v_st(32 + sr, sc);
  const int vb0 = (int)(uintptr_t)V_lds + v_rd_base(lane);
  struct { bf16x8 vs0, vs1, ks0, ks1; } sr_[2];
#define SLOAD(i, k0) do { sr_[i].vs0 = *reinterpret_cast<const bf16x8*>(&Vh[(long)((k0) + sr) * LDK + sc]); sr_[i].vs1 = *reinterpret_cast<const bf16x8*>(&Vh[(long)((k0) + 32 + sr) * LDK + sc]); \
    sr_[i].ks0 = *reinterpret_cast<const bf16x8*>(&Kh[(long)((k0) + sr) * LDK + sc]); sr_[i].ks1 = *reinterpret_cast<const bf16x8*>(&Kh[(long)((k0) + 32 + sr) * LDK + sc]); } while (0)
#define SWRITE(b, i) do { *(bf16x8*)((char*)V_lds + (b) * SHM_V + vst0) = sr_[i].vs0;          \
    *(bf16x8*)((char*)V_lds + (b) * SHM_V + vst1) = sr_[i].vs1; int kc = sc * 2;               \
    *(bf16x8*)((char*)K_lds + (b) * SHM_K + KSWZ(sr, kc)) = sr_[i].ks0;                       \
    *(bf16x8*)((char*)K_lds + (b) * SHM_K + KSWZ(32 + sr, kc)) = sr_[i].ks1; } while (0)
#define SWAIT() asm volatile("s_waitcnt vmcnt(4)" ::: "memory")
#define RESC(a) do { if (__any((a) < 1.f)) { if (hi == 0) al_l[r32] = (a); asm volatile("s_waitcnt lgkmcnt(0)" ::: "memory"); \
    _Pragma("unroll") for (int d = 0; d < 4; ++d) _Pragma("unroll") for (int r = 0; r < 16; ++r) o[d][r] *= al_l[crow(r, hi)]; } } while (0)
  f32x16 pA0, pA1, pB0, pB1; float mnA, mnB, alA, alB; bf16x8 pa0, pa1, pa2, pa3; const int NT = seq / KVBLK;
  constexpr int SE = 0, SO = 1;
  SLOAD(SE, 0); asm volatile("s_waitcnt vmcnt(0)" ::: "memory"); SWRITE(0, SE); __syncthreads();
  qkt(pA0, pA1, K_lds, qr, r32, hi); partialSM(pA0, pA1, m_reg, mnA, alA);
  SLOAD(SO, KVBLK); if (2 < NT) SLOAD(SE, 2 * KVBLK);
  SWAIT(); SWRITE(1, SO); __syncthreads();
  for (int j = 1; j + 1 < NT; j += 2) {
    SBAR(); qkt(pB0, pB1, (bf16_t*)((char*)K_lds + SHM_K), qr, r32, hi);
    finishSM(pA0, pA1, alA, l_reg, pa0, pa1, pa2, pa3); SBAR();
    SLOAD(SO, (j + 2) * KVBLK); SBAR();
    pv_d0(o, vb0, pa0, pa1, pa2, pa3); partialSM(pB0, pB1, m_reg, mnB, alB);
    __syncthreads(); SWAIT(); SWRITE(0, SE);
    RESC(alB); __syncthreads();
    SBAR(); qkt(pA0, pA1, K_lds, qr, r32, hi);
    finishSM(pB0, pB1, alB, l_reg, pa0, pa1, pa2, pa3); SBAR();
    if (j + 3 < NT) SLOAD(SE, (j + 3) * KVBLK); SBAR();
    pv_d0(o, vb0 + (int)SHM_V, pa0, pa1, pa2, pa3); partialSM(pA0, pA1, m_reg, mnA, alA);
    __syncthreads(); SWAIT(); SWRITE(1, SO);
    RESC(alA); __syncthreads();
  }
  SBAR(); qkt(pB0, pB1, (bf16_t*)((char*)K_lds + SHM_K), qr, r32, hi);
  finishSM(pA0, pA1, alA, l_reg, pa0, pa1, pa2, pa3); SBAR();
  pv_d0(o, vb0, pa0, pa1, pa2, pa3); partialSM(pB0, pB1, m_reg, mnB, alB);
  __syncthreads(); RESC(alB);
  finishSM(pB0, pB1, alB, l_reg, pa0, pa1, pa2, pa3); SBAR();
  pv_d0(o, vb0 + (int)SHM_V, pa0, pa1, pa2, pa3);
  if (hi == 0) li_l[r32] = l_reg; asm volatile("s_waitcnt lgkmcnt(0)" ::: "memory");
  float rli[16];
#pragma unroll
  for (int r = 0; r < 16; ++r) rli[r] = __builtin_amdgcn_rcpf(li_l[crow(r, hi)]);
  bf16_t* Ow = Ob + (long)(wid * QBLK) * LDO;
#pragma unroll
  for (int r = 0; r < 16; ++r) { int orow = crow(r, hi);
#pragma unroll
    for (int d0 = 0; d0 < 4; ++d0) Ow[(long)orow * LDO + d0 * 32 + r32] = f2bf(o[d0][r] * rli[r]); }
  __syncthreads();
#undef SLOAD
#undef SWRITE
#undef SWAIT
#undef RESC
}
}

__device__ __forceinline__ void transpose_item(const float* W, int ldw, int k0, int n0, bf16_t* dst, int dld, int drow0, int dcol0, LAS float* scr, int lane) {
  const int kq = lane >> 3, n4 = (lane & 7) * 4;
  f32x4 v[8];
#pragma unroll
  for (int i = 0; i < 8; ++i) v[i] = __builtin_nontemporal_load((const f32x4*)(W + (size_t)(k0 + i * 8 + kq) * ldw + n0 + n4));
#pragma unroll
  for (int i = 0; i < 8; ++i) { LAS float* d = scr + (i * 8 + kq) * 33 + n4; d[0] = v[i][0]; d[1] = v[i][1]; d[2] = v[i][2]; d[3] = v[i][3]; }
  LDS_WAIT();
  const int c = lane & 7;
#pragma unroll
  for (int j = 0; j < 4; ++j) { const int n = (lane >> 3) + 8 * j; const LAS float* s = scr + (8 * c) * 33 + n;
    u32x4 o; o.x = cvt_pk_bf16(s[0 * 33], s[1 * 33]); o.y = cvt_pk_bf16(s[2 * 33], s[3 * 33]); o.z = cvt_pk_bf16(s[4 * 33], s[5 * 33]); o.w = cvt_pk_bf16(s[6 * 33], s[7 * 33]);
    *(u32x4*)(dst + (size_t)(drow0 + n) * dld + dcol0 + 8 * c) = o; }
  LDS_WAIT();
}

__device__ __forceinline__ void ph_prep(LAS unsigned char* lds) {
  CParams& p = *kargs();
  unsigned char* ws = p.ws;
  const int tid = opaque_tid(), lane = tid & 63, wave = tid >> 6, G = gridDim.x, bx = blockIdx.x;
#ifndef PREP_MASK
#define PREP_MASK 63
#endif
  if (PREP_MASK & 1) {
    LAS float* sc = (LAS float*)lds;
    LAS float* red = (LAS float*)(lds + 9 * 1024 * 4);
    for (int i = tid; i < 9 * 1024; i += NTHR) { const int s = i >> 10, k = i & 1023; const float v = s < 8 ? p.in[I_C][s * 1024 + k] : p.in[I_CCTX][k];
      sc[i] = v / (1.f + __expf(-v)); }
    __syncthreads();
    float* MOD = (float*)(ws + WS_MOD);
    typedef float f32x2v __attribute__((ext_vector_type(2)));
    for (int item = bx; item < 4 * 48; item += G) {
      const int l = item / 48, n0 = (item % 48) * 128;
      const float* w = p.in[I_ADAW] + (size_t)l * 1024 * 6144 + (size_t)(wave * 128) * 6144 + n0 + lane * 2;
      float acc[9][2];
#pragma unroll
      for (int s = 0; s < 9; ++s) { acc[s][0] = 0.f; acc[s][1] = 0.f; }
#pragma unroll 32
      for (int k = 0; k < 128; ++k) { const f32x2v wv = __builtin_nontemporal_load((const f32x2v*)(w + (size_t)k * 6144));
#pragma unroll
        for (int s = 0; s < 9; ++s) { const float a = sc[s * 1024 + wave * 128 + k]; acc[s][0] += a * wv.x; acc[s][1] += a * wv.y; } }
#pragma unroll
      for (int s = 0; s < 9; ++s) { red[(wave * 9 + s) * 128 + lane * 2] = acc[s][0]; red[(wave * 9 + s) * 128 + lane * 2 + 1] = acc[s][1]; }
      __syncthreads();
      for (int o = tid; o < 9 * 128; o += NTHR) { const int s = o >> 7, ln = o & 127; float t = 0.f;
#pragma unroll
        for (int ks = 0; ks < 8; ++ks) t += red[(ks * 9 + s) * 128 + ln];
        MOD[((size_t)l * 9 + s) * 6144 + n0 + ln] = t + p.in[I_ADAB][l * 6144 + n0 + ln]; }
      __syncthreads();
    }
  }
  if ((PREP_MASK & 2) && bx == 0) {
    float* RC = (float*)(ws + WS_ROPE); float* RS = RC + 2048;
    for (int i = tid; i < 2048; i += NTHR) { const int pos = i >> 5, fi = i & 31;
      const float inv = exp2f(-(float)fi * (13.287712379549449f / 32.f));
      const float ang = (float)pos * inv;
      const double a = (double)ang; const double kk = rint(a * 0.15915494309189535); const float r = (float)(a - kk * 6.283185307179586);
      RC[i] = __cosf(r); RS[i] = __sinf(r); }
  }
  if (PREP_MASK & 4) {
    LAS float* tab = (LAS float*)(lds + 64 * 1024);
    for (int i = tid; i < 2048; i += NTHR) { const int m = i < 1024 ? i : i - 2048; tab[i] = __cosf((float)m * (6.283185307179586f / 2048.f)); }
    __syncthreads();
    bf16_t* DFTM = (bf16_t*)(ws + WS_DFTM);
    for (int it = bx * NTHR + tid; it < 256 * 512 / 8; it += G * NTHR) {
      const int k = it >> 6, j0 = (it & 63) * 8; unsigned w[4];
#pragma unroll
      for (int q = 0; q < 4; ++q) { float v[2];
#pragma unroll
        for (int h = 0; h < 2; ++h) { const int j = j0 + q * 2 + h; v[h] = j < 256 ? tab[(8 * k * j) & 2047] : -tab[(8 * k * (j - 256) + 512) & 2047]; }
        w[q] = cvt_pk_bf16(v[0], v[1]); }
      *(u32x4*)(DFTM + (size_t)it * 8) = (u32x4){w[0], w[1], w[2], w[3]};
    }
    bf16_t* DFTC = (bf16_t*)(ws + WS_DFTC);
    for (int it = bx * NTHR + tid; it < 256 * 256 / 8; it += G * NTHR) {
      const int k = it >> 5, j0 = (it & 31) * 8; unsigned w[4];
#pragma unroll
      for (int q = 0; q < 4; ++q) { float v[2];
#pragma unroll
        for (int h = 0; h < 2; ++h) { const int j = j0 + q * 2 + h; const int idx = j <= 128 ? (8 * k * j) & 2047 : (8 * k * (j - 128) + 512) & 2047; v[h] = tab[idx]; }
        w[q] = cvt_pk_bf16(v[0], v[1]); }
      *(u32x4*)(DFTC + (size_t)it * 8) = (u32x4){w[0], w[1], w[2], w[3]};
    }
    __syncthreads();
  }
  if (PREP_MASK & 8) {
    LAS float* Wt = (LAS float*)lds;
    LAS float* T = (LAS float*)(lds + 64 * 65 * 4);
    bf16_t* WF = (bf16_t*)(ws + WS_WF);
    for (int item = bx; item < 4 * 4 * 16; item += G) {
      const int l = item >> 6, h = (item >> 4) & 3, kc = item & 15;
      if (tid < 64) { T[tid] = __cosf((float)(tid < 32 ? tid : tid - 64) * (6.283185307179586f / 64.f)); T[64 + tid] = __sinf((float)(tid < 32 ? tid : tid - 64) * (6.283185307179586f / 64.f)); }
      { float tv[8];
#pragma unroll
        for (int q = 0; q < 8; ++q) { const int i = tid + q * NTHR, kk = i >> 6, c = i & 63; tv[q] = p.in[I_WIN][(size_t)l * 1024 * 1536 + (size_t)(kc * 64 + kk) * 1536 + h * 64 + c]; }
#pragma unroll
        for (int q = 0; q < 8; ++q) { const int i = tid + q * NTHR, kk = i >> 6, c = i & 63; Wt[kk * 65 + c] = tv[q]; } }
      __syncthreads();
      float wrow[64];
#pragma unroll
      for (int c = 0; c < 64; ++c) wrow[c] = Wt[lane * 65 + c];
#pragma unroll 1
      for (int jj = 0; jj < 8; ++jj) { const int jp = wave * 8 + jj, cs = jp >= 33 ? 1 : 0, lq = cs ? jp - 32 : jp; float a = 0.f;
        asm volatile("" ::: "memory");
#pragma unroll
        for (int c = 0; c < 64; ++c) a += wrow[c] * T[cs * 64 + ((lq * c) & 63)];
        WF[((size_t)l * 256 + h * 64 + jp) * 1024 + kc * 64 + lane] = f2bf(a); }
      __syncthreads();
    }
  }
  if (PREP_MASK & 16) {
    LAS float* As = (LAS float*)lds;
    LAS float* Bs = (LAS float*)(lds + 64 * 256 * 4);
    bf16_t* WO = (bf16_t*)(ws + WS_WO);
    for (int item = bx; item < 4 * 8 * 16; item += G) {
      const int l = item >> 7, kt = (item >> 4) & 7, ntile = item & 15;
      const int M = kt < 4 ? 256 : 64;
      const float* wout = p.in[I_WOUT] + (size_t)l * 1024 * 1024;
      if (kt < 4) {
        const float* wf = p.in[I_WFOU] + (size_t)l * 256 * 256 + (size_t)(kt * 64) * 256;
        { f32x4 ta[8], tb[8];
#pragma unroll
          for (int q = 0; q < 8; ++q) { const int i = tid + q * NTHR; ta[q] = *(const f32x4*)(wf + i * 4); const int m = i >> 4, n4 = (i & 15) * 4; tb[q] = *(const f32x4*)(wout + (size_t)m * 1024 + ntile * 64 + n4); }
#pragma unroll
          for (int q = 0; q < 8; ++q) { const int i = tid + q * NTHR; *(LAS f32x4*)(As + i * 4) = ta[q]; *(LAS f32x4*)(Bs + i * 4) = tb[q]; } }
      } else {
        const int g = kt - 4;
        const float* wp = p.in[I_WPOOL] + (size_t)l * 4 * 64 * 64 + (size_t)g * 64 * 64;
        const float* ps = p.in[I_PSCALE] + l * 256 + g * 64;
        { f32x4 ta[2], tb[2], tp[2];
#pragma unroll
          for (int q = 0; q < 2; ++q) { const int i = tid + q * NTHR; ta[q] = *(const f32x4*)(wp + i * 4); tp[q] = *(const f32x4*)(ps + (i & 15) * 4); const int m = i >> 4, n4 = (i & 15) * 4; tb[q] = *(const f32x4*)(wout + (size_t)(256 + g * 64 + m) * 1024 + ntile * 64 + n4); }
#pragma unroll
          for (int q = 0; q < 2; ++q) { const int i = tid + q * NTHR; *(LAS f32x4*)(As + i * 4) = ta[q] * tp[q]; *(LAS f32x4*)(Bs + i * 4) = tb[q]; } }
      }
      __syncthreads();
      float acc[8];
#pragma unroll
      for (int i = 0; i < 8; ++i) acc[i] = 0.f;
      for (int m = 0; m < M; m += 4) {
        const float b0 = Bs[(m + 0) * 64 + lane], b1 = Bs[(m + 1) * 64 + lane], b2 = Bs[(m + 2) * 64 + lane], b3 = Bs[(m + 3) * 64 + lane];
#pragma unroll
        for (int i = 0; i < 8; ++i) { const f32x4 a = *(const LAS f32x4*)(As + (wave * 8 + i) * M + m); acc[i] += a[0] * b0 + a[1] * b1 + a[2] * b2 + a[3] * b3; }
      }
      u32x4 o; o.x = cvt_pk_bf16(acc[0], acc[1]); o.y = cvt_pk_bf16(acc[2], acc[3]); o.z = cvt_pk_bf16(acc[4], acc[5]); o.w = cvt_pk_bf16(acc[6], acc[7]);
      *(u32x4*)(WO + ((size_t)l * 1024 + ntile * 64 + lane) * 1024 + kt * 64 + wave * 8) = o;
      __syncthreads();
    }
  }
  if (PREP_MASK & 32) {
    LAS float* scr = (LAS float*)(lds + wave * (64 * 33 * 4));
    constexpr int PER_L = 640 + 256;
    const int gw = bx * NWAVE + wave, NGW = G * NWAVE;
    for (int it = gw; it < 4 * PER_L; it += NGW) {
      const int l = it / PER_L; int r = it % PER_L;
      if (r < 640) { const int kb = r / 40, nb = r % 40;
        transpose_item(p.in[I_WIN] + (size_t)l * 1024 * 1536 + 256, 1536, kb * 64, nb * 32, (bf16_t*)(ws + WS_WP) + (size_t)l * 1280 * 1024, 1024, nb * 32, kb * 64, scr, lane); continue; }
      r -= 640;
      { const int kb = r >> 5, nb = r & 31;
        transpose_item(p.in[I_WOUT] + (size_t)l * 1024 * 1024 + (size_t)512 * 1024, 1024, kb * 64, nb * 32, (bf16_t*)(ws + WS_WO) + (size_t)l * 1024 * 1024, 1024, nb * 32, 512 + kb * 64, scr, lane); }
    }
  }
  __syncthreads();
}

__device__ __forceinline__ void moe_item_addr(CParams& p, unsigned char* ws, int l, int r, const float*& src, bf16_t*& dst, int& k0, int& n0, int& drow0) {
  const int e = r / 1536, q = r % 1536, mat = q >> 9, item = q & 511, kb = item >> 5, nb = item & 31;
  n0 = nb * 32; k0 = kb * 64;
  const size_t eoff = (size_t)e * 1024 * 1024, goff = ((size_t)l * 16 + e) * 1024 * 1024;
  if (mat == 2) { src = p.in[I_WDOWN] + goff; dst = (bf16_t*)(ws + ((l & 1) ? WS_WD2 : WS_WD)) + eoff; drow0 = n0; }
  else { src = (mat ? p.in[I_WUP] : p.in[I_WGATE]) + goff; dst = (bf16_t*)(ws + ((l & 1) ? WS_WGU2 : WS_WGU)) + eoff * 2; drow0 = (n0 >> 7) * 256 + mat * 128 + (n0 & 127); }
}
__device__ __forceinline__ void convert_moe_weights(int l, int rank, int nranks, int lo, int hi, LAS unsigned char* lds) {
  CParams& p = *kargs();
  unsigned char* ws = p.ws;
  const int tid = opaque_tid(), lane = tid & 63, wave = tid >> 6;
  LAS float* scr = (LAS float*)(lds + wave * (64 * 33 * 4));
  const int kq = lane >> 3, n4 = (lane & 7) * 4, c = lane & 7;
  const int step = nranks * NWAVE;
  int r = lo + rank * NWAVE + wave;
  f32x4 v[8];
  const float* src; bf16_t* dst; int k0, n0, drow0;
  if (r < hi) { moe_item_addr(p, ws, l, r, src, dst, k0, n0, drow0);
#pragma unroll
    for (int i = 0; i < 8; ++i) v[i] = __builtin_nontemporal_load((const f32x4*)(src + (size_t)(k0 + i * 8 + kq) * 1024 + n0 + n4)); }
  while (r < hi) {
    const int rn = r + step;
    f32x4 vn[8]; const float* srcn; bf16_t* dstn = dst; int k0n = k0, n0n = n0, drow0n = drow0;
    if (rn < hi) { moe_item_addr(p, ws, l, rn, srcn, dstn, k0n, n0n, drow0n);
#pragma unroll
      for (int i = 0; i < 8; ++i) vn[i] = __builtin_nontemporal_load((const f32x4*)(srcn + (size_t)(k0n + i * 8 + kq) * 1024 + n0n + n4)); }
    else {
#pragma unroll
      for (int i = 0; i < 8; ++i) vn[i] = v[i]; }
#pragma unroll
    for (int i = 0; i < 8; ++i) { LAS float* d = scr + (i * 8 + kq) * 33 + n4; d[0] = v[i][0]; d[1] = v[i][1]; d[2] = v[i][2]; d[3] = v[i][3]; }
    LDS_WAIT();
#pragma unroll
    for (int j = 0; j < 4; ++j) { const int n = (lane >> 3) + 8 * j; const LAS float* s = scr + (8 * c) * 33 + n;
      u32x4 o; o.x = cvt_pk_bf16(s[0 * 33], s[1 * 33]); o.y = cvt_pk_bf16(s[2 * 33], s[3 * 33]); o.z = cvt_pk_bf16(s[4 * 33], s[5 * 33]); o.w = cvt_pk_bf16(s[6 * 33], s[7 * 33]);
      *(u32x4*)(dst + (size_t)(drow0 + n) * 1024 + k0 + 8 * c) = o; }
    LDS_WAIT();
#pragma unroll
    for (int i = 0; i < 8; ++i) v[i] = vn[i];
    r = rn; dst = dstn; k0 = k0n; n0 = n0n; drow0 = drow0n;
  }
  __syncthreads();
}

__device__ __forceinline__ void moe_combine2(const int* slotrow, const bf16_t* YY, int lane, f32x4 (&a)[2][4]) {
  const int smA = lane < 16 ? slotrow[lane] : -1, smB = lane < 16 ? slotrow[16 + lane] : -1;
  unsigned mA = (unsigned)__ballot(smA >= 0), mB = (unsigned)__ballot(smB >= 0);
#pragma unroll
  for (int u = 0; u < 2; ++u)
#pragma unroll
    for (int j = 0; j < 4; ++j) a[u][j] = (f32x4){0.f, 0.f, 0.f, 0.f};
  while (mA | mB) {
    const int eA = mA ? __builtin_ctz(mA) : 0, eB = mB ? __builtin_ctz(mB) : 0;
    const bool hA = mA != 0u, hB = mB != 0u;
    mA &= mA - 1u; mB &= mB - 1u;
    const int yA = hA ? __shfl(smA, eA) : 0, yB = hB ? __shfl(smB, eB) : 0;
    const bf16_t* pA = YY + (size_t)yA * 1024 + lane * 4; const bf16_t* pB = YY + (size_t)yB * 1024 + lane * 4;
    u32x2 wA[4], wB[4];
#pragma unroll
    for (int j = 0; j < 4; ++j) { wA[j] = *(const u32x2*)(pA + 256 * j); wB[j] = *(const u32x2*)(pB + 256 * j); }
    const float fA = hA ? 1.f : 0.f, fB = hB ? 1.f : 0.f;
#pragma unroll
    for (int j = 0; j < 4; ++j) {
      a[0][j][0] += fA * __uint_as_float(wA[j].x << 16); a[0][j][1] += fA * __uint_as_float(wA[j].x & 0xffff0000u); a[0][j][2] += fA * __uint_as_float(wA[j].y << 16); a[0][j][3] += fA * __uint_as_float(wA[j].y & 0xffff0000u);
      a[1][j][0] += fB * __uint_as_float(wB[j].x << 16); a[1][j][1] += fB * __uint_as_float(wB[j].x & 0xffff0000u); a[1][j][2] += fB * __uint_as_float(wB[j].y << 16); a[1][j][3] += fB * __uint_as_float(wB[j].y & 0xffff0000u); }
  }
}

__device__ __forceinline__ void ph_mod1(int l) {
  CParams& p = *kargs();
  unsigned char* ws = p.ws;
  const int tid = opaque_tid(), lane = tid & 63, wave = tid >> 6;
  const int gw = blockIdx.x * NWAVE + wave, NGW = gridDim.x * NWAVE;
  const float* MOD = (const float*)(ws + WS_MOD);
  bf16_t* X = (bf16_t*)(ws + WS_X); const bf16_t* XMID = (const bf16_t*)(ws + WS_XMID); bf16_t* HX = (bf16_t*)(ws + WS_HX);
  const int* SLOT = (const int*)(ws + WS_SLOT); const bf16_t* YY = (const bf16_t*)(ws + WS_XS);
  const float* ng = p.in[I_N1G] + l * 1024;
  for (int pr = gw; pr < NTOK / 2; pr += NGW) {
    const int row0 = pr * 2;
    const int s = row0 < NLAT ? row0 >> 11 : 8;
    f32x4 v[2][4];
    if (l == 0) {
#pragma unroll
      for (int u = 0; u < 2; ++u) { const int row = row0 + u; const float* src = row < NLAT ? p.in[I_X] + (size_t)row * 1024 : p.in[I_CTX] + (size_t)(row - NLAT) * 1024;
#pragma unroll
        for (int j = 0; j < 4; ++j) v[u][j] = *(const f32x4*)(src + lane * 4 + 256 * j); }
    } else {
#pragma unroll
      for (int u = 0; u < 2; ++u)
#pragma unroll
        for (int j = 0; j < 4; ++j) v[u][j] = ld4bf(XMID + (size_t)(row0 + u) * 1024 + lane * 4 + 256 * j);
      f32x4 a[2][4]; moe_combine2(SLOT + (size_t)row0 * 16, YY, lane, a);
      const float* g2 = MOD + ((size_t)(l - 1) * 9 + s) * 6144 + 5120;
#pragma unroll
      for (int j = 0; j < 4; ++j) { const f32x4 g = *(const f32x4*)(g2 + lane * 4 + 256 * j); v[0][j] += g * a[0][j]; v[1][j] += g * a[1][j]; }
    }
    const float* ml = MOD + ((size_t)l * 9 + s) * 6144;
#pragma unroll
    for (int u = 0; u < 2; ++u) { const int row = row0 + u;
      float ss = 0.f;
#pragma unroll
      for (int j = 0; j < 4; ++j) { st4bf(X + (size_t)row * 1024 + lane * 4 + 256 * j, v[u][j]); ss += v[u][j][0] * v[u][j][0] + v[u][j][1] * v[u][j][1] + v[u][j][2] * v[u][j][2] + v[u][j][3] * v[u][j][3]; }
      const float r = rsqrtf(wave_sum(ss) * (1.f / 1024.f) + EPS);
#pragma unroll
      for (int j = 0; j < 4; ++j) { const int c = lane * 4 + 256 * j;
        const f32x4 g = *(const f32x4*)(ng + c), sh = *(const f32x4*)(ml + c), scl = *(const f32x4*)(ml + 1024 + c);
        const f32x4 y = v[u][j] * r * g * (scl + 1.f) + sh;
        u32x2 w; w.x = cvt_pk_bf16(y[0], y[1]); w.y = cvt_pk_bf16(y[2], y[3]);
        *(u32x2*)(HX + (size_t)row * 1024 + c) = w; } }
  }
}

__device__ __forceinline__ void ph_final() {
  CParams& p = *kargs();
  unsigned char* ws = p.ws;
  const int tid = opaque_tid(), lane = tid & 63, wave = tid >> 6;
  const int gw = blockIdx.x * NWAVE + wave, NGW = gridDim.x * NWAVE;
  const float* MOD = (const float*)(ws + WS_MOD); const bf16_t* XMID = (const bf16_t*)(ws + WS_XMID);
  const int* SLOT = (const int*)(ws + WS_SLOT); const bf16_t* YY = (const bf16_t*)(ws + WS_XS);
  for (int pr = gw; pr < NLAT / 2; pr += NGW) {
    const int row0 = pr * 2, s = row0 >> 11;
    f32x4 v[2][4];
#pragma unroll
    for (int u = 0; u < 2; ++u)
#pragma unroll
      for (int j = 0; j < 4; ++j) v[u][j] = ld4bf(XMID + (size_t)(row0 + u) * 1024 + lane * 4 + 256 * j);
    f32x4 a[2][4]; moe_combine2(SLOT + (size_t)row0 * 16, YY, lane, a);
    const float* g2 = MOD + ((size_t)(DEPTH - 1) * 9 + s) * 6144 + 5120;
#pragma unroll
    for (int j = 0; j < 4; ++j) { const f32x4 g = *(const f32x4*)(g2 + lane * 4 + 256 * j);
      *(f32x4*)(p.out + (size_t)row0 * 1024 + lane * 4 + 256 * j) = v[0][j] + g * a[0][j];
      *(f32x4*)(p.out + (size_t)(row0 + 1) * 1024 + lane * 4 + 256 * j) = v[1][j] + g * a[1][j]; }
  }
}

__device__ __forceinline__ void unpack8(const u32x4 w, float (&f)[8]) {
  f[0] = __uint_as_float(w.x << 16); f[1] = __uint_as_float(w.x & 0xffff0000u); f[2] = __uint_as_float(w.y << 16); f[3] = __uint_as_float(w.y & 0xffff0000u);
  f[4] = __uint_as_float(w.z << 16); f[5] = __uint_as_float(w.z & 0xffff0000u); f[6] = __uint_as_float(w.w << 16); f[7] = __uint_as_float(w.w & 0xffff0000u);
}
__device__ __forceinline__ u32x4 pack8(const float (&f)[8]) { u32x4 o; o.x = cvt_pk_bf16(f[0], f[1]); o.y = cvt_pk_bf16(f[2], f[3]); o.z = cvt_pk_bf16(f[4], f[5]); o.w = cvt_pk_bf16(f[6], f[7]); return o; }
__device__ __forceinline__ u32x4 head_norm_rope(const u32x4 w, const float (&g)[8], const bool rope, const f32x4 c0, const f32x4 c1, const f32x4 s0, const f32x4 s1, const float sgn) {
  float f[8]; unpack8(w, f);
  float ss = 0.f;
#pragma unroll
  for (int k = 0; k < 8; ++k) ss += f[k] * f[k];
  ss += __shfl_xor(ss, 1); ss += __shfl_xor(ss, 2); ss += __shfl_xor(ss, 4); ss += __shfl_xor(ss, 8);
  const float r = rsqrtf(ss * (1.f / 128.f) + EPS);
#pragma unroll
  for (int k = 0; k < 8; ++k) f[k] *= r * g[k];
  if (rope) { float o[8];
#pragma unroll
    for (int k = 0; k < 8; ++k) { const float pk = __shfl_xor(f[k], 4); const float cs = k < 4 ? c0[k & 3] : c1[k & 3], sn = k < 4 ? s0[k & 3] : s1[k & 3]; o[k] = f[k] * cs + sgn * pk * sn; }
    return pack8(o); }
  return pack8(f);
}
__device__ __forceinline__ void ph_post(int l, LAS unsigned char* lds) {
  CParams& p = *kargs();
  unsigned char* ws = p.ws;
  const int tid = opaque_tid(), lane = tid & 63, wave = tid >> 6;
  const int gw = blockIdx.x * NWAVE + wave, NGW = gridDim.x * NWAVE;
  const bf16_t* PX = (const bf16_t*)(ws + WS_PX);
  bf16_t* QR = (bf16_t*)(ws + WS_QR); bf16_t* KR = (bf16_t*)(ws + WS_KR); bf16_t* VR = (bf16_t*)(ws + WS_VR); bf16_t* CAT = (bf16_t*)(ws + WS_CAT);
  const float* RC = (const float*)(ws + WS_ROPE); const float* RS = RC + 2048;
  float qg[8], kg[8];
  { const f32x4 a = *(const f32x4*)(p.in[I_QG] + l * 128 + (lane & 15) * 8), b = *(const f32x4*)(p.in[I_QG] + l * 128 + (lane & 15) * 8 + 4);
    const f32x4 c = *(const f32x4*)(p.in[I_KG] + l * 128 + (lane & 15) * 8), d = *(const f32x4*)(p.in[I_KG] + l * 128 + (lane & 15) * 8 + 4);
#pragma unroll
    for (int k = 0; k < 4; ++k) { qg[k] = a[k]; qg[4 + k] = b[k]; kg[k] = c[k]; kg[4 + k] = d[k]; } }
  const float sgn = (lane & 4) ? 1.f : -1.f;
  const int half = lane >> 5, l32 = lane & 31, gi = l32 >> 3, w2 = 1 << gi;
  { const bf16_t* YT = (const bf16_t*)(ws + WS_YT); const bf16_t* YTC = (const bf16_t*)(ws + WS_YTC); bf16_t* YF = (bf16_t*)(ws + WS_YF); bf16_t* YFC = (bf16_t*)(ws + WS_YFC);
    const int gt = blockIdx.x * NTHR + tid, ngt = gridDim.x * NTHR;
    {
      LAS bf16_t* rowbuf = (LAS bf16_t*)lds;
      LAS float* ctab = (LAS float*)(lds + 16384);
      for (int i = tid; i < 2048; i += NTHR) { const int m = i < 1024 ? i : i - 2048; ctab[i] = __cosf((float)m * (6.283185307179586f / 2048.f)); }
      constexpr float C8[8] = {1.f, 0.70710678118654752f, 0.f, -0.70710678118654752f, -1.f, -0.70710678118654752f, 0.f, 0.70710678118654752f};
      for (int rp = blockIdx.x; rp < 1024; rp += gridDim.x) {
        __syncthreads();
#pragma unroll
        for (int hh = 0; hh < 2; ++hh) { const int rr = rp * 2 + hh, bb = rr >> 8, lo = rr & 63, lc = lo <= 32 ? lo : 64 - lo, part = tid >> 8;
          const int srow = bb * 256 + ((rr >> 6) & 3) * 64 + (part ? 32 + lc : lc); const bool have = part == 0 || (lc >= 1 && lc <= 31);
          u32x4 w = (u32x4){0u, 0u, 0u, 0u}; if (have) w = *(const u32x4*)(YT + (size_t)srow * 2048 + (tid & 255) * 8);
          *(LAS u32x4*)(rowbuf + hh * 4096 + tid * 8) = w; }
        __syncthreads();
        const int h = tid >> 8, t2 = tid & 255, r = rp * 2 + h, b = r >> 8, hl = r & 255;
        const LAS bf16_t* src = rowbuf + h * 4096;
        const float sgn = (r & 63) > 32 ? -1.f : 1.f;
        float a[8], sv[8];
#pragma unroll
        for (int t1 = 0; t1 < 8; ++t1) { a[t1] = bf2f(src[256 * t1 + t2]); sv[t1] = sgn * bf2f(src[2048 + 256 * t1 + t2]); }
#pragma unroll
        for (int k1 = 0; k1 < 8; ++k1) { float xr = 0.f, xi = 0.f;
#pragma unroll
          for (int t1 = 0; t1 < 8; ++t1) { const float c = C8[(t1 * k1) & 7], sn = C8[((t1 * k1) + 6) & 7]; xr += a[t1] * c - sv[t1] * sn; xi -= a[t1] * sn + sv[t1] * c; }
          const int idx = (t2 * k1) & 2047; const float ct = ctab[idx], st = ctab[(idx + 1536) & 2047];
          bf16_t* dst = YF + (((size_t)(b * 8 + k1) * 256 + hl) * 512) + t2;
          dst[0] = f2bf(xr * ct + xi * st); dst[256] = f2bf(xi * ct - xr * st); }
      }
      __syncthreads(); }
    if (l != DEPTH - 1)
    for (int idx = gt; idx < 8 * 256 * 256; idx += ngt) { const int u = idx & 255, r = idx >> 8, lo = r & 63, lc = lo <= 32 ? lo : 64 - lo; float v;
      const bf16_t* C = YTC + (size_t)((r >> 8) * 256 + ((r >> 6) & 3) * 64 + lc) * 256; const bf16_t* S = C + 32 * 256;
      if (u <= 128) { v = bf2f(C[u]); if (u != 0 && u != 128) v += bf2f(C[256 - u]); }
      else { const int t = u - 128; v = (lc >= 1 && lc <= 31) ? (lo > 32 ? -1.f : 1.f) * (bf2f(S[t]) - bf2f(S[256 - t])) : 0.f; }
      YFC[idx] = f2bf(v); }
  }
  for (int pr = gw; pr < NTOK / 2; pr += NGW) {
    const int row0 = pr * 2;
    const bool lat = row0 < NLAT;
    const int b = lat ? row0 >> 11 : (row0 - NLAT) >> 8, t0 = lat ? row0 & 2047 : (row0 - NLAT) & 255, n = lat ? 2048 : 256;
    u32x4 kv[2];
#pragma unroll
    for (int u = 0; u < 2; ++u) { const bf16_t* px = PX + (size_t)(row0 + u) * 1280; kv[u] = *(const u32x4*)(px + 768 + lane * 8); }
    f32x4 c0[2], c1[2], s0[2], s1[2];
#pragma unroll
    for (int u = 0; u < 2; ++u) { const int t = t0 + u; const int pos = ((lane >> 3) & 1) ? (t & 63) : (t >> 6); const int o = pos * 32 + (lane & 3) * 8;
      c0[u] = *(const f32x4*)(RC + o); c1[u] = *(const f32x4*)(RC + o + 4); s0[u] = *(const f32x4*)(RS + o); s1[u] = *(const f32x4*)(RS + o + 4); }
    { const int t = t0 + half; const int lo = max(t - w2, 0), hi = min(t + w2, n);
      const bf16_t* base = PX + (size_t)(row0 - t0) * 1280 + l32 * 8;
      float acc[8], ctr[8];
#pragma unroll
      for (int k = 0; k < 8; ++k) acc[k] = 0.f;
      u32x4 wv[16];
#pragma unroll
      for (int r = 0; r < 16; ++r) { const int tr = t - 8 + r; const bool ok = tr >= lo && tr < hi; const int trc = ok ? tr : t;
        wv[r] = *(const u32x4*)(base + (size_t)trc * 1280); }
#pragma unroll
      for (int r = 0; r < 16; ++r) { const int tr = t - 8 + r; const bool ok = tr >= lo && tr < hi; float f[8]; unpack8(wv[r], f);
        if (r == 8) {
#pragma unroll
          for (int k = 0; k < 8; ++k) ctr[k] = f[k]; }
#pragma unroll
        for (int k = 0; k < 8; ++k) acc[k] += ok ? f[k] : 0.f; }
      const float ic = 1.f / (float)(hi - lo); float d[8];
#pragma unroll
      for (int k = 0; k < 8; ++k) d[k] = acc[k] * ic - ctr[k];
      *(u32x4*)(CAT + (size_t)(row0 + half) * 1024 + 256 + l32 * 8) = pack8(d); }
#pragma unroll
    for (int u = 0; u < 2; ++u) { const int row = row0 + u, t = t0 + u;
      const u32x4 kk = head_norm_rope(kv[u], kg, lat, c0[u], c1[u], s0[u], s1[u], sgn);
      const size_t kvrow = (size_t)b * KVLEN + (lat ? t : SEQ + t);
      if (lane < 32) *(u32x4*)(KR + kvrow * 256 + lane * 8) = kk; else *(u32x4*)(VR + kvrow * 256 + (lane - 32) * 8) = kv[u]; }
  }
}

__device__ __forceinline__ void ph_mod2(int l, LAS unsigned char* lds) {
  const int nrows = (l == DEPTH - 1) ? NLAT : NTOK;
  CParams& p = *kargs();
  unsigned char* ws = p.ws;
  const int tid = opaque_tid(), lane = tid & 63, wave = tid >> 6;
  const int gw = blockIdx.x * NWAVE + wave, NGW = gridDim.x * NWAVE;
  LAS float* wrt = (LAS float*)lds;
  const float* wr_g = p.in[I_WROUTER] + (size_t)l * 1024 * 16;
  for (int i = tid; i < 1024 * 16 / 4; i += NTHR) { const f32x4 w = *(const f32x4*)(wr_g + i * 4); const int c = i >> 2, e4 = (i & 3) * 4;
    wrt[(e4 + 0) * 1024 + c] = w[0]; wrt[(e4 + 1) * 1024 + c] = w[1]; wrt[(e4 + 2) * 1024 + c] = w[2]; wrt[(e4 + 3) * 1024 + c] = w[3]; }
  __syncthreads();
  const float* MOD = (const float*)(ws + WS_MOD); const bf16_t* XMID = (const bf16_t*)(ws + WS_XMID); bf16_t* HX = (bf16_t*)(ws + WS_HX);
  float* AFF = (float*)(ws + WS_AFF);
  const float* ng = p.in[I_N2G] + l * 1024;
  for (int pr = gw; pr < nrows / 2; pr += NGW) {
    const int row0 = pr * 2;
    const bool lat = row0 < NLAT; const int s = lat ? row0 >> 11 : 8;
    f32x4 y[2][4]; float ss[2];
#pragma unroll
    for (int u = 0; u < 2; ++u) { ss[u] = 0.f;
#pragma unroll
      for (int j = 0; j < 4; ++j) { y[u][j] = ld4bf(XMID + (size_t)(row0 + u) * 1024 + lane * 4 + 256 * j); ss[u] += y[u][j][0] * y[u][j][0] + y[u][j][1] * y[u][j][1] + y[u][j][2] * y[u][j][2] + y[u][j][3] * y[u][j][3]; } }
    const float r0 = rsqrtf(wave_sum(ss[0]) * (1.f / 1024.f) + EPS), r1 = rsqrtf(wave_sum(ss[1]) * (1.f / 1024.f) + EPS);
    const float* ml = MOD + ((size_t)l * 9 + s) * 6144;
    float lg[2][16];
#pragma unroll
    for (int e = 0; e < 16; ++e) { lg[0][e] = 0.f; lg[1][e] = 0.f; }
#pragma unroll 1
    for (int j = 0; j < 4; ++j) { const int c = lane * 4 + 256 * j;
      const f32x4 g = *(const f32x4*)(ng + c), sh = *(const f32x4*)(ml + 3072 + c), scl = *(const f32x4*)(ml + 4096 + c);
      y[0][j] = y[0][j] * r0 * g * (scl + 1.f) + sh; y[1][j] = y[1][j] * r1 * g * (scl + 1.f) + sh;
      st4bf(HX + (size_t)row0 * 1024 + c, y[0][j]); st4bf(HX + (size_t)(row0 + 1) * 1024 + c, y[1][j]);
#pragma unroll
      for (int e = 0; e < 16; ++e) { const f32x4 wv = *(const LAS f32x4*)(wrt + e * 1024 + c);
        lg[0][e] += y[0][j][0] * wv[0] + y[0][j][1] * wv[1] + y[0][j][2] * wv[2] + y[0][j][3] * wv[3];
        lg[1][e] += y[1][j][0] * wv[0] + y[1][j][1] * wv[1] + y[1][j][2] * wv[2] + y[1][j][3] * wv[3];
        if ((e & 7) == 7) asm volatile("" ::: "memory"); } }
#pragma unroll
    for (int u = 0; u < 2; ++u) {
      float a8[8], a4[4], a2[2];
#pragma unroll
      for (int i = 0; i < 8; ++i) { const bool hb = (lane & 32) != 0; const float snd = hb ? lg[u][i] : lg[u][8 + i], kp = hb ? lg[u][8 + i] : lg[u][i]; a8[i] = kp + __shfl_xor(snd, 32); }
#pragma unroll
      for (int i = 0; i < 4; ++i) { const bool hb = (lane & 16) != 0; const float snd = hb ? a8[i] : a8[4 + i], kp = hb ? a8[4 + i] : a8[i]; a4[i] = kp + __shfl_xor(snd, 16); }
#pragma unroll
      for (int i = 0; i < 2; ++i) { const bool hb = (lane & 8) != 0; const float snd = hb ? a4[i] : a4[2 + i], kp = hb ? a4[2 + i] : a4[i]; a2[i] = kp + __shfl_xor(snd, 8); }
      float mine; { const bool hb = (lane & 4) != 0; const float snd = hb ? a2[0] : a2[1], kp = hb ? a2[1] : a2[0]; mine = kp + __shfl_xor(snd, 4); }
      mine += __shfl_xor(mine, 1); mine += __shfl_xor(mine, 2);
      float mx = mine;
#pragma unroll
      for (int o = 4; o < 64; o <<= 1) mx = fmaxf(mx, __shfl_xor(mx, o));
      const float ex = __expf(mine - mx); float sm = ex;
#pragma unroll
      for (int o = 4; o < 64; o <<= 1) sm += __shfl_xor(sm, o);
      const float aff = ex / sm;
      const int e = ((lane >> 5) & 1) * 8 + ((lane >> 4) & 1) * 4 + ((lane >> 3) & 1) * 2 + ((lane >> 2) & 1), row = row0 + u;
      if ((lane & 3) == 0) { if (lat) AFF[((size_t)(row >> 11) * 16 + e) * 2048 + (row & 2047)] = aff;
        else { const int rc = row - NLAT; AFF[(size_t)128 * 2048 + ((size_t)(rc >> 8) * 16 + e) * 256 + (rc & 255)] = aff; } }
    }
  }
  __syncthreads();
}

__device__ __forceinline__ void ph_topk(int l, LAS unsigned char* lds) {
  const int nprob = (l == DEPTH - 1) ? 128 : 256;
  CParams& p = *kargs();
  unsigned char* ws = p.ws;
  const int tid = opaque_tid(), lane = tid & 63, wave = tid >> 6;
  LAS unsigned* hist = (LAS unsigned*)lds;
  LAS unsigned* wtot = hist + 256;
  LAS unsigned* res = hist + 272;
  const float* AFF = (const float*)(ws + WS_AFF); float* GATE = (float*)(ws + WS_GATE); int* SLOT = (int*)(ws + WS_SLOT);
  int* IDX = (int*)(ws + WS_IDX);
  for (int q = blockIdx.x; q < nprob; q += gridDim.x) {
    const bool lat = q < 128; const int qq = lat ? q : q - 128; const int b = qq >> 4, e = qq & 15;
    const int n = lat ? 2048 : 256, cap = lat ? CAPL : CAPC;
    const float* aff = AFF + (lat ? (size_t)qq * 2048 : (size_t)128 * 2048 + (size_t)qq * 256);
    const int i0 = tid * 4; const bool valid = i0 < n;
    unsigned k[4];
    { f32x4 a4 = (f32x4){0.f, 0.f, 0.f, 0.f}; if (valid) a4 = *(const f32x4*)(aff + i0);
#pragma unroll
      for (int r = 0; r < 4; ++r) k[r] = __float_as_uint(a4[r]); }
    unsigned prefix = 0u, mask = 0u, remaining = (unsigned)cap;
    for (int shift = 24; shift >= 0; shift -= 8) {
      __syncthreads();
      if (tid < 256) hist[tid] = 0u;
      __syncthreads();
      if (valid) {
#pragma unroll
        for (int r = 0; r < 4; ++r) if ((k[r] & mask) == prefix) atomicAdd((unsigned*)&hist[(k[r] >> shift) & 255u], 1u); }
      __syncthreads();
      unsigned hv = 0u, sfx = 0u;
      if (tid < 256) { hv = hist[tid]; sfx = hv;
#pragma unroll
        for (int o = 1; o < 64; o <<= 1) { const unsigned t = __shfl_down(sfx, o); if (lane + o < 64) sfx += t; }
        if (lane == 0) wtot[wave] = sfx; }
      __syncthreads();
      if (tid < 256) { unsigned above = 0u;
#pragma unroll
        for (int w = 1; w < 4; ++w) if (w > wave) above += wtot[w];
        const unsigned incl = sfx + above, excl = incl - hv;
        if (excl < remaining && remaining <= incl) { res[0] = (unsigned)tid; res[1] = remaining - excl; res[2] = hv; } }
      __syncthreads();
      prefix |= res[0] << shift; mask |= 255u << shift; remaining = res[1];
    }
    const unsigned T = prefix, need_eq = remaining, tot_eq = res[2];
    bool sel[4]; int cnt = 0;
#pragma unroll
    for (int r = 0; r < 4; ++r) { bool sl = valid && (k[r] > T || (k[r] == T && tot_eq == need_eq));
      if (valid && k[r] == T && tot_eq != need_eq) { unsigned rk = 0u; for (int j = 0; j < i0 + r; ++j) rk += (__float_as_uint(aff[j]) == T) ? 1u : 0u; sl = rk < need_eq; }
      sel[r] = sl; cnt += sl ? 1 : 0; }
    int incl = cnt;
#pragma unroll
    for (int o = 1; o < 64; o <<= 1) { const int t = __shfl_up(incl, o); if (lane >= o) incl += t; }
    __syncthreads();
    if (lane == 63) wtot[wave] = (unsigned)incl;
    __syncthreads();
    int base = incl - cnt;
#pragma unroll
    for (int w = 0; w < 8; ++w) if (w < wave) base += (int)wtot[w];
    const int tokbase = lat ? b * SEQ : NLAT + b * CTXL;
    const int yrow0 = e * EROWS + (lat ? b * CAPL : NB * CAPL + b * CAPC);
    if (valid) {
#pragma unroll
      for (int r = 0; r < 4; ++r) { const int tok = tokbase + i0 + r;
        if (sel[r]) { SLOT[(size_t)tok * 16 + e] = yrow0 + base; GATE[yrow0 + base] = __uint_as_float(k[r]); IDX[yrow0 + base] = tok; ++base; }
        else SLOT[(size_t)tok * 16 + e] = -1; } }
    __syncthreads();
  }
}

#ifndef PH_MASK
#define PH_MASK 0xFFFF
#endif
#ifndef DUP_MASK
#define DUP_MASK 0
#endif
#define REPS(bit) for (int rep_ = 0; rep_ < 1 + ((DUP_MASK & (bit)) ? 1 : 0); ++rep_)
#define GSYNC() do { xcd_barrier(xst); if (DUP_MASK & 4096) xcd_barrier(xst); } while (0)
__global__ void __launch_bounds__(NTHR, 2) fwd_mega(Params p) {
  extern __shared__ __attribute__((aligned(16))) unsigned char lds_raw[];
  LAS unsigned char* lds = (LAS unsigned char*)lds_raw;
  cg::grid_group grid = cg::this_grid();
  const int G = gridDim.x;
  const int bx = (G % 8 == 0) ? ((int)blockIdx.x % 8) * (G / 8) + (int)blockIdx.x / 8 : (int)blockIdx.x;

  volatile LAS unsigned* xst = (volatile LAS unsigned*)(lds + 131072);
  if (threadIdx.x == 0) { xst[0] = 0u; xst[1] = 0u; }
  __syncthreads();
  xcd_barrier_post((unsigned*)(kargs()->ws + WS_BAR));
  REPS(1) if (PH_MASK & 1) ph_prep(lds);
  GSYNC();
  if (gridDim.x == 0x7fffffffu) grid.sync();

  for (int l = 0; l < DEPTH; ++l) {
    const bool last = (l == DEPTH - 1);
    REPS(2) if (PH_MASK & 2) ph_mod1(l);
    GSYNC();
    REPS(4) if (PH_MASK & 4) {
      unsigned char* ws = kargs()->ws;
      pg8::Gemm g{(const bf16_t*)(ws + WS_HX), (const bf16_t*)(ws + WS_WP) + (size_t)l * 1280 * 1024, 1024, 1024, 1024};
      pg8::Sched S{72, 5, 360, G, bx, 72};
      pg8::EpiBf16 E{(bf16_t*)(ws + WS_PX), 1280};
      pg8::gemm_phase<pg8::EpiBf16>(lds, g, S, E);
    }
    REPS(4) if (PH_MASK & 8) {
      unsigned char* ws = kargs()->ws;
      pg8::Gemm g{(const bf16_t*)(ws + WS_WF) + (size_t)l * 256 * 1024, (const bf16_t*)(ws + WS_HX), 1024, 1024, 1024};
      pg8::Sched S{1, 72, 72, G, (bx + G - (360 % G)) % G, 1};
      pg8::EpiYT E{(bf16_t*)(ws + WS_YT), (bf16_t*)(ws + WS_YTC)};
      pg8::gemm_phase<pg8::EpiYT>(lds, g, S, E);
    }
    GSYNC();
    REPS(16) if (PH_MASK & 16) ph_post(l, lds);
    GSYNC();
    REPS(32) if (PH_MASK & 32) {
      unsigned char* ws = kargs()->ws;
      const bf16_t* QR = (const bf16_t*)(ws + WS_QR); const bf16_t* KR = (const bf16_t*)(ws + WS_KR); const bf16_t* VR = (const bf16_t*)(ws + WS_VR); bf16_t* CAT = (bf16_t*)(ws + WS_CAT);
      REPS(16384) for (int u = bx; u < (last ? 256 : 288); u += G) {
        const bool lat = u < 256; const int uu = lat ? u : u - 256;
        const int b = lat ? uu >> 5 : uu >> 2, h = lat ? (uu >> 3) & 3 : uu & 3, qb = lat ? uu & 7 : 0;
        const size_t tok = lat ? (size_t)b * SEQ + qb * 256 : (size_t)NLAT + b * CTXL;
        const size_t kv = ((size_t)b * KVLEN + (lat ? 0 : SEQ)) * 256 + (h >> 1) * 128;
        att::attn_dense_body((const bf16_t*)(ws + WS_PX) + tok * 1280 + 256 + h * 128, KR + kv, VR + kv, CAT + tok * 1024 + 512 + h * 128, lat ? KVLEN : CTXL, (char*)lds_raw,
                             kargs()->in[I_QG] + l * 128, (const float*)(ws + WS_ROPE), (const float*)(ws + WS_ROPE) + 2048, lat, qb * 256);
      }
      { pg8::Gemm g{(const bf16_t*)(ws + WS_DFTM), (const bf16_t*)(ws + WS_YF), 512, 512, 512};
        pg8::Sched S{1, 64, 64, G, (bx + G - (32 % G)) % G, 1};
        pg8::EpiDft2 E{CAT, 0.0027621358640099515f};
        pg8::gemm_phase<pg8::EpiDft2>(lds, g, S, E); }
      { pg8::Gemm g{(const bf16_t*)(ws + WS_DFTC), (const bf16_t*)(ws + WS_YFC), 256, 256, 256};
        pg8::Sched S{1, 8, last ? 0 : 8, G, (bx + G - (96 % G)) % G, 1};
        pg8::EpiDft E{CAT, NLAT, CTXL, 0.0078125f};
        pg8::gemm_phase<pg8::EpiDft>(lds, g, S, E); }
      { const int cq = (bx + G - (32 % G)) % G;
        const int clo = (l > 0 && G == 256) ? (last ? CONV_C : CONV_B) : 0;
        const int chi = (last || G != 256) ? 16 * 1536 : (l == 0 ? CONV_SPLIT : CONV_B);
        const int s1 = (G <= 72) ? chi : clo + ((chi - clo) / 4) * 3;
        if (chi > clo) { convert_moe_weights(l, bx, G, clo, s1, lds);
          if (G > 72 && cq >= 72) convert_moe_weights(l, cq - 72, G - 72, s1, chi, lds); } }
    }
    GSYNC();
    REPS(64) if (PH_MASK & 64) {
      unsigned char* ws = kargs()->ws;
      pg8::Gemm g{(const bf16_t*)(ws + WS_CAT), (const bf16_t*)(ws + WS_WO) + (size_t)l * 1024 * 1024, 1024, 1024, 1024};
      pg8::Sched S{last ? 64 : 72, 4, last ? 256 : 288, G, bx, 72};
      pg8::EpiOut E{(const bf16_t*)(ws + WS_X), (bf16_t*)(ws + WS_XMID), (const float*)(ws + WS_MOD) + (size_t)l * 9 * 6144};
      pg8::gemm_phase<pg8::EpiOut>(lds, g, S, E);
      if (!last && G == 256 && bx >= 32) { convert_moe_weights(l, bx - 32, G - 32, l == 0 ? CONV_SPLIT : CONV_B, 16 * 1536, lds);
        if (l == DEPTH - 2) convert_moe_weights(l + 1, bx - 32, G - 32, CONV_B, CONV_C, lds); }
    }
    GSYNC();
    REPS(128) if (PH_MASK & 128) ph_mod2(l, lds);
    GSYNC();
    REPS(256) if (PH_MASK & 256) ph_topk(l, lds);
    GSYNC();
    REPS(512) if (PH_MASK & 512) {
      unsigned char* ws = kargs()->ws;
      pg8::Gemm g{(const bf16_t*)(ws + WS_HX), (const bf16_t*)(ws + ((l & 1) ? WS_WGU2 : WS_WGU)), 1024, 1024, 1024};
      pg8::Sched S{last ? 8 : 9, 8, last ? 16 * 64 : 16 * 72, G, bx, 9};
      pg8::EpiMoe1 E{(bf16_t*)(ws + WS_HH)};
      pg8::gemm_phase_gather<pg8::EpiMoe1>(lds, g, (const int*)(ws + WS_IDX), S, E);
      if (!last && G == 256 && bx >= 128) convert_moe_weights(l + 1, bx - 128, 128, 0, CONV_A, lds);
    }
    GSYNC();
    REPS(1024) if (PH_MASK & 1024) {
      unsigned char* ws = kargs()->ws;
      pg8::Gemm g{(const bf16_t*)(ws + WS_HH), (const bf16_t*)(ws + ((l & 1) ? WS_WD2 : WS_WD)), 1024, 1024, 1024};
      pg8::Sched S{last ? 8 : 9, 4, last ? 16 * 32 : 16 * 36, G, bx, 9};
      pg8::EpiMoe2 E{(bf16_t*)(ws + WS_XS), (const float*)(ws + WS_GATE)};
      pg8::gemm_phase<pg8::EpiMoe2>(lds, g, S, E);
      if (!last && G == 256 && bx >= 64) convert_moe_weights(l + 1, bx - 64, 192, CONV_A, CONV_B, lds);
    }
    GSYNC();
  }
  if (PH_MASK & 2048) ph_final();
}

extern "C" void kernel_launch(void* const* d_in, const int* in_sizes, int n_in, void* d_out, int out_size,
                              void* d_ws, size_t ws_size, hipStream_t stream) {
  static int grid_blocks = 0;
  if (grid_blocks == 0) {
    if (n_in != N_IN || out_size != NLAT * DM || ws_size < WS_END) {
      fprintf(stderr, "kernel_launch: unexpected shapes: n_in %d out %d ws %zu (need %zu)\n", n_in, out_size, ws_size, (size_t)WS_END); grid_blocks = -1; return; }
    int dev = 0, cus = 0, per_cu = 0;
    if (hipGetDevice(&dev) != hipSuccess || hipDeviceGetAttribute(&cus, hipDeviceAttributeMultiprocessorCount, dev) != hipSuccess) { grid_blocks = -1; return; }
    if (hipFuncSetAttribute((const void*)fwd_mega, hipFuncAttributeMaxDynamicSharedMemorySize, LDS_BYTES) != hipSuccess) { fprintf(stderr, "kernel_launch: hipFuncSetAttribute failed\n"); grid_blocks = -1; return; }
    if (hipOccupancyMaxActiveBlocksPerMultiprocessor(&per_cu, (const void*)fwd_mega, NTHR, LDS_BYTES) != hipSuccess || per_cu < 1) { fprintf(stderr, "kernel_launch: occupancy query says %d\n", per_cu); per_cu = 1; }
    (void)hipGetLastError();
    grid_blocks = cus;
  }
  if (grid_blocks < 0) return;
  Params p{};
  for (int i = 0; i < N_IN; ++i) p.in[i] = (const float*)d_in[i];
  p.out = (float*)d_out; p.ws = (unsigned char*)d_ws;
  if (hipMemsetAsync((char*)d_ws + WS_BAR, 0, 16384, stream) != hipSuccess) { fprintf(stderr, "kernel_launch: memset failed\n"); return; }
  void* args[] = {&p};
  hipError_t e = hipLaunchCooperativeKernel((void*)fwd_mega, dim3(grid_blocks), dim3(NTHR), args, LDS_BYTES, stream);
  if (e != hipSuccess) fprintf(stderr, "cooperative launch failed: %s (grid %d)\n", hipGetErrorString(e), grid_blocks);
}
```

```cpp
#include <hip/hip_runtime.h>
#include <hip/hip_cooperative_groups.h>
#include <cstdio>
#include <cstdint>
namespace cg = cooperative_groups;

typedef unsigned short bf16_t;
typedef short bf16x8 __attribute__((ext_vector_type(8)));
typedef short s16x4 __attribute__((ext_vector_type(4)));
typedef float f32x4 __attribute__((ext_vector_type(4)));
typedef float f32x16 __attribute__((ext_vector_type(16)));
typedef unsigned u32x4 __attribute__((ext_vector_type(4)));
typedef unsigned u32x2 __attribute__((ext_vector_type(2)));
#define LAS __attribute__((address_space(3)))

constexpr int DM = 1024, NB = 8, SEQ = 2048, CTXL = 256, NLAT = NB * SEQ, NCTX = NB * CTXL, NTOK = NLAT + NCTX, DEPTH = 4;
constexpr int NE = 16, CAPL = 256, CAPC = 32, EROWS = NB * CAPL + NB * CAPC;
constexpr int KVLEN = SEQ + CTXL;
constexpr float EPS = 1e-6f;
constexpr int NTHR = 512, NWAVE = 8;
constexpr int LDS_BYTES = 132 * 1024;
constexpr int CONV_SPLIT = 11264;

enum { I_X = 0, I_C, I_CTX, I_CCTX, I_ADAW, I_ADAB, I_N1G, I_N2G, I_WIN, I_WFOU, I_WPOOL, I_PSCALE, I_QG, I_KG, I_WOUT, I_WROUTER, I_WGATE, I_WUP, I_WDOWN, N_IN };
struct Params { const float* in[N_IN]; float* out; unsigned char* ws; };
typedef const __attribute__((address_space(4))) Params CParams;
__device__ __forceinline__ CParams* kargs() { CParams* q = (CParams*)__builtin_amdgcn_kernarg_segment_ptr(); asm volatile("" : "+s"(q)); return q; }

constexpr size_t al256(size_t x) { return (x + 255) & ~(size_t)255; }
constexpr size_t WS_BAR  = 0;
constexpr size_t WS_MOD  = 16384;
constexpr size_t WS_ROPE = WS_MOD + al256((size_t)4 * 9 * 6144 * 4);
constexpr size_t WS_DFTM = WS_ROPE + al256((size_t)2 * 2048 * 4);
constexpr size_t WS_DFTC = WS_DFTM + (size_t)2048 * 4096 * 2;
constexpr size_t WS_WF   = WS_DFTC + (size_t)256 * 512 * 2;
constexpr size_t WS_WP   = WS_WF + (size_t)4 * 512 * 1024 * 2;
constexpr size_t WS_WO   = WS_WP + (size_t)4 * 1280 * 1024 * 2;
constexpr size_t WS_WGU  = WS_WO + (size_t)4 * 1024 * 1024 * 2;
constexpr size_t WS_WD   = WS_WGU + (size_t)16 * 2048 * 1024 * 2;
constexpr size_t WS_X    = WS_WD + (size_t)16 * 1024 * 1024 * 2;
constexpr size_t WS_XMID = WS_X + (size_t)NTOK * 1024 * 4;
constexpr size_t WS_HX   = WS_XMID + (size_t)NTOK * 1024 * 4;
constexpr size_t WS_AFF  = WS_HX + (size_t)NTOK * 1024 * 2;
constexpr size_t WS_GATE = WS_AFF + (size_t)(8 * 16 * 2048 + 8 * 16 * 256) * 4;
constexpr size_t WS_IDX  = WS_GATE + al256((size_t)16 * 2304 * 4);
constexpr size_t WS_SLOT = WS_IDX + al256((size_t)16 * 2304 * 4);
constexpr size_t WS_R1   = WS_SLOT + (size_t)NTOK * 16 * 4;
constexpr size_t WS_PX   = WS_R1;
constexpr size_t WS_YT   = WS_PX + (size_t)NTOK * 1280 * 2;
constexpr size_t WS_YTC  = WS_YT + (size_t)8 * 256 * 4096 * 2;
constexpr size_t WS_QR   = WS_YTC + (size_t)8 * 256 * 512 * 2;
constexpr size_t WS_KR   = WS_QR + (size_t)NTOK * 512 * 2;
constexpr size_t WS_VR   = WS_KR + (size_t)8 * 2304 * 256 * 2;
constexpr size_t WS_CAT  = WS_VR + (size_t)8 * 2304 * 256 * 2;
constexpr size_t WS_YF   = WS_CAT + (size_t)NTOK * 1024 * 2;
constexpr size_t WS_YFC  = WS_YF + (size_t)8 * 8 * 256 * 512 * 2;
constexpr size_t WS_R1A_END = WS_YFC + (size_t)8 * 256 * 256 * 2;
constexpr size_t WS_XS   = WS_R1;
constexpr size_t WS_HH   = WS_XS + (size_t)16 * 2304 * 1024 * 2;
constexpr size_t WS_R1B_END = WS_HH + (size_t)16 * 2304 * 1024 * 2;
constexpr size_t WS_END0 = WS_R1A_END > WS_R1B_END ? WS_R1A_END : WS_R1B_END;

constexpr size_t WS_WGU2 = WS_END0;
constexpr size_t WS_WD2  = WS_WGU2 + (size_t)16 * 2048 * 1024 * 2;
constexpr size_t WS_END  = WS_WD2 + (size_t)16 * 1024 * 1024 * 2;
constexpr int CONV_P = 4608;
constexpr int CONV_A = 6144, CONV_B = 15360, CONV_C = 21504;
constexpr int CONV_UNUSED_ = 0;

__device__ __forceinline__ int opaque_tid() { int t = threadIdx.x; asm volatile("" : "+v"(t)); return t; }
__device__ __forceinline__ unsigned cvt_pk_bf16(float lo, float hi) { unsigned r; asm volatile("v_cvt_pk_bf16_f32 %0, %1, %2" : "=v"(r) : "v"(lo), "v"(hi)); return r; }
__device__ __forceinline__ float bf2f(bf16_t b) { return __uint_as_float(((unsigned)b) << 16); }
__device__ __forceinline__ bf16_t f2bf(float f) { return (bf16_t)(cvt_pk_bf16(f, 0.f) & 0xffffu); }
__device__ __forceinline__ float wave_sum(float v) {
#pragma unroll
  for (int o = 1; o < 64; o <<= 1) v += __shfl_xor(v, o);
  return v;
}
#define LDS_WAIT() asm volatile("s_waitcnt lgkmcnt(0)" ::: "memory")
__device__ __forceinline__ f32x4 ld4bf(const bf16_t* p) { const u32x2 w = *(const u32x2*)p; return (f32x4){__uint_as_float(w.x << 16), __uint_as_float(w.x & 0xffff0000u), __uint_as_float(w.y << 16), __uint_as_float(w.y & 0xffff0000u)}; }
__device__ __forceinline__ void st4bf(bf16_t* p, const f32x4 v) { u32x2 w; w.x = cvt_pk_bf16(v[0], v[1]); w.y = cvt_pk_bf16(v[2], v[3]); *(u32x2*)p = w; }


#define XB_TMO      128
#define XB_XCNT(j)  (256  + 64 * (j))
#define XB_XSUB(j)  (1280 + 64 * (j))
#define XB_XGEN(j)  (2304 + 64 * (j))
#define XB_TOP      3328
#define XB_TOPGEN   3392
#define XCD_BAR_WORDS 3456
#define XB_SPIN_CAP (1u << 18)
__device__ __forceinline__ unsigned xb_ld(unsigned* p)              { return __hip_atomic_load(p, __ATOMIC_RELAXED, __HIP_MEMORY_SCOPE_AGENT); }
__device__ __forceinline__ unsigned xb_add(unsigned* p, unsigned v) { return __hip_atomic_fetch_add(p, v, __ATOMIC_RELAXED, __HIP_MEMORY_SCOPE_AGENT); }
__device__ __forceinline__ unsigned xb_xcc_id() { return (unsigned)__builtin_amdgcn_s_getreg((3 << 11) | 20) & 0xFu; }
#define XB_SPIN(cond, bar) do { unsigned _sp = 0; while (cond) { __builtin_amdgcn_s_sleep(1); \
    if ((++_sp & 255u) == 0u) { if (xb_ld(&(bar)[XB_TMO])) break; if (_sp > XB_SPIN_CAP) { atomicAdd(&(bar)[XB_TMO], 1u); break; } } } } while (0)
__device__ __forceinline__ void xcd_barrier_post(unsigned* bar) { if (threadIdx.x == 0) (void)xb_add(&bar[XB_XCNT(xb_xcc_id())], 1u); }
__device__ __forceinline__ void xcd_barrier_complete(unsigned* bar, unsigned x, unsigned& nloc, unsigned& nx) {
    const unsigned G = gridDim.x * gridDim.y * gridDim.z;
    unsigned sum, cnt, mine, sp = 0u;
    for (;;) {
        sum = 0u; cnt = 0u; mine = 0u;
#pragma unroll
        for (unsigned j = 0; j < 16; ++j) { const unsigned c = xb_ld(&bar[XB_XCNT(j)]); sum += c; cnt += (c > 0u) ? 1u : 0u; mine = (j == x) ? c : mine; }
        if (sum == G) break;
        __builtin_amdgcn_s_sleep(1);
        if ((++sp & 255u) == 0u) { if (xb_ld(&bar[XB_TMO])) break; if (sp > XB_SPIN_CAP) { atomicAdd(&bar[XB_TMO], 1u); break; } }
    }
    nloc = mine > 0u ? mine : 1u; nx = cnt > 0u ? cnt : 1u;
}
__device__ __forceinline__ void xcd_barrier(volatile LAS unsigned* st) {
    asm volatile("s_waitcnt vmcnt(0)" ::: "memory");
    __syncthreads();
    if (threadIdx.x == 0) {
        unsigned* bar = (unsigned*)(kargs()->ws + WS_BAR); const unsigned x = xb_xcc_id();
        __builtin_amdgcn_s_waitcnt(0);
        unsigned nloc = st[0], nx = st[1];
        if (nloc == 0u) { xcd_barrier_complete(bar, x, nloc, nx); st[0] = nloc; st[1] = nx; }
        const unsigned old = xb_add(&bar[XB_XSUB(x)], 1u);
        const unsigned gen = old / nloc;
        if (old + 1u == (gen + 1u) * nloc) {
            __builtin_amdgcn_fence(__ATOMIC_RELEASE, "agent");
            asm volatile("s_waitcnt vmcnt(0)" ::: "memory");
            const unsigned og = xb_add(&bar[XB_TOP], 1u);
            const unsigned tg = og / nx;
            if (og + 1u == (tg + 1u) * nx) xb_add(&bar[XB_TOPGEN], 1u);
            else XB_SPIN(xb_ld(&bar[XB_TOPGEN]) == tg, bar);
            __builtin_amdgcn_fence(__ATOMIC_ACQUIRE, "agent");
            xb_add(&bar[XB_XGEN(x)], 1u);
            asm volatile("s_waitcnt vmcnt(0)" ::: "memory");
        } else {
            XB_SPIN(xb_ld(&bar[XB_XGEN(x)]) == gen, bar);
            __builtin_amdgcn_fence(__ATOMIC_ACQUIRE, "agent");
            asm volatile("s_waitcnt vmcnt(0)" ::: "memory");
        }
    }
    __syncthreads();
}

namespace pg8 {
constexpr int BM = 256, BK = 64, HALF = 128, HTB = HALF * BK * 2, STAGE_BYTES = 8 * HTB;
__device__ __forceinline__ int lds_byte(int r, int c) { const int st = (r >> 4) * 2 + (c >> 5), rr = r & 15, cc = c & 31, ob = rr * 64 + cc * 2; return st * 1024 + (ob ^ (((ob >> 9) & 1) << 5)); }
__device__ __forceinline__ void stage_rc(int b, int& R, int& C) { const int st = b / 1024, sb = b % 1024, swz = sb ^ (((sb >> 9) & 1) << 5); R = (st >> 1) * 16 + swz / 64; C = (st & 1) * 32 + (swz % 64) / 2; }
__device__ __forceinline__ int perm32(int rho) { const int n = rho >> 4, i = rho & 15; return 8 * (i >> 2) + 4 * n + (i & 3); }

struct Unit { int pm, pn; };
struct Gemm { const bf16_t* A; const bf16_t* Bt; int lda, ldb, K; };

struct Sched {
  int gm, gn, total, G, c, gs;
  __device__ __forceinline__ bool next(int i, Unit& u) const {
    const long L = (long)i * G + c; if (L >= total) return false;
    const int per = gm * gn, g = (int)L / per, r = (int)L % per;
    u.pm = g * gs + r / gn; u.pn = g * gn + r % gn; return true;
  }
};

template <class Epi>
__device__ __forceinline__ void gemm_phase(LAS unsigned char* lds, const Gemm g, const Sched& S, const Epi& E) {
  const int tid = opaque_tid(), wid = __builtin_amdgcn_readfirstlane(tid >> 6), lane = tid & 63, wr = wid >> 2, wc = wid & 3, fr = lane & 15, fq = lane >> 4;
  const int K = g.K, nt = K / BK;
  unsigned voffA[2], voffB[2];
#pragma unroll
  for (int i = 0; i < 2; ++i) { int R, C; stage_rc(tid * 16 + i * 8192, R, C); const int Rb = Epi::PERM ? ((R & ~31) + perm32(R & 31)) : R;
    voffA[i] = (unsigned)(R * g.lda + C) * 2u; voffB[i] = (unsigned)(Rb * g.ldb + C) * 2u; }
  const size_t kstep = (size_t)(BK * 2);
  const size_t hstepA = (size_t)HALF * g.lda * 2, hstepB = (size_t)HALF * g.ldb * 2;
  const size_t tstepA = 2 * hstepA, tstepB = 2 * hstepB;
  const unsigned ldsw = (unsigned)wid * 1024u;
  const int aoff = lds_byte(wr * 64 + fr, fq * 8), boff = lds_byte(wc * 32 + fr, fq * 8);
#define PG8_SA(b, h) (((b) * 2 + (h)) * HTB)
#define PG8_SB(b, h) ((4 + (b) * 2 + (h)) * HTB)
#define PG8_STAGE(bufoff, gbase, voff) do { _Pragma("unroll") for (int _i = 0; _i < 2; ++_i) \
    __builtin_amdgcn_global_load_lds((const unsigned*)((const char*)(gbase) + (voff)[_i]), (LAS unsigned*)(lds + (bufoff) + ldsw + _i * 8192), 16, 0, 0); } while (0)
#define PG8_LDA(dst, b, h) do { _Pragma("unroll") for (int m = 0; m < 4; ++m) _Pragma("unroll") for (int k = 0; k < 2; ++k) dst[m][k] = *(const LAS bf16x8*)(lds + PG8_SA(b, h) + aoff + m * 2048 + k * 1024); } while (0)
#define PG8_LDB(dst, b, h) do { _Pragma("unroll") for (int n = 0; n < 2; ++n) _Pragma("unroll") for (int k = 0; k < 2; ++k) dst[n][k] = *(const LAS bf16x8*)(lds + PG8_SB(b, h) + boff + n * 2048 + k * 1024); } while (0)
#define PG8_MMA(ai, bj, At, Bt) do { __builtin_amdgcn_s_setprio(1); _Pragma("unroll") for (int m = 0; m < 4; ++m) _Pragma("unroll") for (int n = 0; n < 2; ++n) _Pragma("unroll") for (int k = 0; k < 2; ++k) \
    acc[ai][bj][m][n] = __builtin_amdgcn_mfma_f32_16x16x32_bf16(Bt[n][k], At[m][k], acc[ai][bj][m][n], 0, 0, 0); __builtin_amdgcn_s_setprio(0); } while (0)
#define PG8_WAIT_V(n) asm volatile("s_waitcnt vmcnt(" #n ")" ::: "memory")
#define PG8_WAIT_L(n) asm volatile("s_waitcnt lgkmcnt(" #n ")" ::: "memory")
#define PG8_BAR __builtin_amdgcn_s_barrier()
#define PG8_SCHED __builtin_amdgcn_sched_barrier(0)
  Unit cur, nxt; int ui = 0;
  if (!S.next(0, cur)) return;
  f32x4 acc[2][2][4][2];
#pragma unroll
  for (int a = 0; a < 2; ++a)
#pragma unroll
    for (int b = 0; b < 2; ++b)
#pragma unroll
      for (int m = 0; m < 4; ++m)
#pragma unroll
        for (int n = 0; n < 2; ++n) acc[a][b][m][n] = (f32x4){0.f, 0.f, 0.f, 0.f};
  bf16x8 At[4][2], B0[2][2], B1[2][2];
  const char* cA = (const char*)g.A + (size_t)cur.pm * tstepA; const char* cB = (const char*)g.Bt + (size_t)cur.pn * tstepB;
  PG8_STAGE(PG8_SB(0, 0), cB, voffB); PG8_STAGE(PG8_SA(0, 0), cA, voffA); PG8_STAGE(PG8_SB(0, 1), cB + hstepB, voffB); PG8_STAGE(PG8_SA(0, 1), cA + hstepA, voffA);
  if (wr == 1) PG8_BAR;
  PG8_WAIT_V(4); PG8_BAR;
  PG8_STAGE(PG8_SB(1, 0), cB + kstep, voffB); PG8_STAGE(PG8_SA(1, 0), cA + kstep, voffA); PG8_STAGE(PG8_SB(1, 1), cB + hstepB + kstep, voffB);
  PG8_WAIT_V(6); PG8_BAR;
  for (;;) {
    const bool has_next = S.next(ui + 1, nxt);
    const char* nA = has_next ? (const char*)g.A + (size_t)nxt.pm * tstepA : cA; const char* nB = has_next ? (const char*)g.Bt + (size_t)nxt.pn * tstepB : cB;
    for (int t = 0; t < nt; t += 2) {
      const bool last = (t == nt - 2);
      const char* a1 = cA + (size_t)(t + 1) * kstep;
      const char* a2 = last ? nA : cA + (size_t)(t + 2) * kstep; const char* b2 = last ? nB : cB + (size_t)(t + 2) * kstep;
      const char* a3 = a2 + kstep; const char* b3 = b2 + kstep;
      PG8_LDB(B0, 0, 0); PG8_SCHED; PG8_LDA(At, 0, 0); PG8_STAGE(PG8_SA(1, 1), a1 + hstepA, voffA);
      PG8_WAIT_L(8); PG8_BAR; PG8_WAIT_L(0); PG8_MMA(0, 0, At, B0); PG8_BAR; PG8_SCHED;
      PG8_LDB(B1, 0, 1); PG8_STAGE(PG8_SB(0, 0), b2, voffB);
      PG8_BAR; PG8_WAIT_L(0); PG8_MMA(0, 1, At, B1); PG8_BAR;
      PG8_LDA(At, 0, 1); PG8_STAGE(PG8_SA(0, 0), a2, voffA);
      PG8_BAR; PG8_WAIT_L(0); PG8_MMA(1, 0, At, B0); PG8_BAR; PG8_SCHED;
      PG8_STAGE(PG8_SB(0, 1), b2 + hstepB, voffB);
      PG8_WAIT_V(6); PG8_BAR; PG8_MMA(1, 1, At, B1); PG8_BAR;
      PG8_LDB(B0, 1, 0); PG8_SCHED; PG8_LDA(At, 1, 0); PG8_STAGE(PG8_SA(0, 1), a2 + hstepA, voffA);
      PG8_WAIT_L(8); PG8_BAR; PG8_WAIT_L(0); PG8_MMA(0, 0, At, B0); PG8_BAR; PG8_SCHED;
      PG8_LDB(B1, 1, 1); PG8_STAGE(PG8_SB(1, 0), b3, voffB);
      PG8_BAR; PG8_WAIT_L(0); PG8_MMA(0, 1, At, B1); PG8_BAR;
      PG8_LDA(At, 1, 1); PG8_STAGE(PG8_SA(1, 0), a3, voffA);
      PG8_BAR; PG8_WAIT_L(0); PG8_MMA(1, 0, At, B0); PG8_BAR; PG8_SCHED;
      PG8_STAGE(PG8_SB(1, 1), b3 + hstepB, voffB);
      PG8_WAIT_V(6); PG8_BAR; PG8_MMA(1, 1, At, B1); PG8_BAR;
    }
    E(acc, cur, wr, wc, fr, fq);
#if defined(DUP_MASK)
    if (DUP_MASK & 8192) E(acc, cur, wr, wc, fr, fq);
#endif
    if (!has_next) break;
#pragma unroll
    for (int a = 0; a < 2; ++a)
#pragma unroll
      for (int b = 0; b < 2; ++b)
#pragma unroll
        for (int m = 0; m < 4; ++m)
#pragma unroll
          for (int n = 0; n < 2; ++n) acc[a][b][m][n] = (f32x4){0.f, 0.f, 0.f, 0.f};
    cur = nxt; cA = nA; cB = nB; ++ui;
  }
  PG8_WAIT_V(0);
  if (wr == 0) PG8_BAR;
  PG8_BAR;
#undef PG8_SA
#undef PG8_SB
#undef PG8_STAGE
#undef PG8_LDA
#undef PG8_LDB
#undef PG8_MMA
#undef PG8_WAIT_V
#undef PG8_WAIT_L
#undef PG8_BAR
#undef PG8_SCHED
}

template <class Epi>
__device__ __forceinline__ void gemm_phase_gather(LAS unsigned char* lds, const Gemm g, const int* __restrict__ rowidx, const Sched& S, const Epi& E) {
  const int tid = opaque_tid(), wid = __builtin_amdgcn_readfirstlane(tid >> 6), lane = tid & 63, wr = wid >> 2, wc = wid & 3, fr = lane & 15, fq = lane >> 4;
  const int K = g.K, nt = K / BK;
  unsigned voffB[2]; int Rr[2], Cc[2];
#pragma unroll
  for (int i = 0; i < 2; ++i) { int R, C; stage_rc(tid * 16 + i * 8192, R, C); const int Rb = Epi::PERM ? ((R & ~31) + perm32(R & 31)) : R;
    Rr[i] = R; Cc[i] = C; voffB[i] = (unsigned)(Rb * g.ldb + C) * 2u; }
  unsigned vc0[2], vc1[2], vn0[2], vn1[2];
#define PG8_ROWOFF(v0, v1, u) do { _Pragma("unroll") for (int _i = 0; _i < 2; ++_i) { \
    v0[_i] = (unsigned)(rowidx[(u).pm * 256 + Rr[_i]] * g.lda + Cc[_i]) * 2u; v1[_i] = (unsigned)(rowidx[(u).pm * 256 + 128 + Rr[_i]] * g.lda + Cc[_i]) * 2u; } } while (0)
  const size_t kstep = (size_t)(BK * 2);
  const size_t hstepB = (size_t)HALF * g.ldb * 2;
  const size_t tstepB = 2 * hstepB;
  const unsigned ldsw = (unsigned)wid * 1024u;
  const int aoff = lds_byte(wr * 64 + fr, fq * 8), boff = lds_byte(wc * 32 + fr, fq * 8);
#define PG8_SA(b, h) (((b) * 2 + (h)) * HTB)
#define PG8_SB(b, h) ((4 + (b) * 2 + (h)) * HTB)
#define PG8_STAGE(bufoff, gbase, voff) do { _Pragma("unroll") for (int _i = 0; _i < 2; ++_i) \
    __builtin_amdgcn_global_load_lds((const unsigned*)((const char*)(gbase) + (voff)[_i]), (LAS unsigned*)(lds + (bufoff) + ldsw + _i * 8192), 16, 0, 0); } while (0)
#define PG8_LDA(dst, b, h) do { _Pragma("unroll") for (int m = 0; m < 4; ++m) _Pragma("unroll") for (int k = 0; k < 2; ++k) dst[m][k] = *(const LAS bf16x8*)(lds + PG8_SA(b, h) + aoff + m * 2048 + k * 1024); } while (0)
#define PG8_LDB(dst, b, h) do { _Pragma("unroll") for (int n = 0; n < 2; ++n) _Pragma("unroll") for (int k = 0; k < 2; ++k) dst[n][k] = *(const LAS bf16x8*)(lds + PG8_SB(b, h) + boff + n * 2048 + k * 1024); } while (0)
#define PG8_MMA(ai, bj, At, Bt) do { __builtin_amdgcn_s_setprio(1); _Pragma("unroll") for (int m = 0; m < 4; ++m) _Pragma("unroll") for (int n = 0; n < 2; ++n) _Pragma("unroll") for (int k = 0; k < 2; ++k) \
    acc[ai][bj][m][n] = __builtin_amdgcn_mfma_f32_16x16x32_bf16(Bt[n][k], At[m][k], acc[ai][bj][m][n], 0, 0, 0); __builtin_amdgcn_s_setprio(0); } while (0)
#define PG8_WAIT_V(n) asm volatile("s_waitcnt vmcnt(" #n ")" ::: "memory")
#define PG8_WAIT_L(n) asm volatile("s_waitcnt lgkmcnt(" #n ")" ::: "memory")
#define PG8_BAR __builtin_amdgcn_s_barrier()
#define PG8_SCHED __builtin_amdgcn_sched_barrier(0)
  Unit cur, nxt; int ui = 0;
  if (!S.next(0, cur)) return;
  f32x4 acc[2][2][4][2];
#pragma unroll
  for (int a = 0; a < 2; ++a)
#pragma unroll
    for (int b = 0; b < 2; ++b)
#pragma unroll
      for (int m = 0; m < 4; ++m)
#pragma unroll
        for (int n = 0; n < 2; ++n) acc[a][b][m][n] = (f32x4){0.f, 0.f, 0.f, 0.f};
  bf16x8 At[4][2], B0[2][2], B1[2][2];
  const char* cA = (const char*)g.A; const char* cB = (const char*)g.Bt + (size_t)cur.pn * tstepB;
  PG8_ROWOFF(vc0, vc1, cur);
  PG8_STAGE(PG8_SB(0, 0), cB, voffB); PG8_STAGE(PG8_SA(0, 0), cA, vc0); PG8_STAGE(PG8_SB(0, 1), cB + hstepB, voffB); PG8_STAGE(PG8_SA(0, 1), cA, vc1);
  if (wr == 1) PG8_BAR;
  PG8_WAIT_V(4); PG8_BAR;
  PG8_STAGE(PG8_SB(1, 0), cB + kstep, voffB); PG8_STAGE(PG8_SA(1, 0), cA + kstep, vc0); PG8_STAGE(PG8_SB(1, 1), cB + hstepB + kstep, voffB);
  PG8_WAIT_V(6); PG8_BAR;
  for (;;) {
    const bool has_next = S.next(ui + 1, nxt);
    const char* nB = has_next ? (const char*)g.Bt + (size_t)nxt.pn * tstepB : cB;
    if (has_next) PG8_ROWOFF(vn0, vn1, nxt); else { vn0[0] = vc0[0]; vn0[1] = vc0[1]; vn1[0] = vc1[0]; vn1[1] = vc1[1]; }
    for (int t = 0; t < nt; t += 2) {
      const bool last = (t == nt - 2);
      const char* a1 = cA + (size_t)(t + 1) * kstep;
      const char* a2 = last ? cA : cA + (size_t)(t + 2) * kstep; const char* b2 = last ? nB : cB + (size_t)(t + 2) * kstep;
      unsigned s0[2], s1[2]; s0[0] = last ? vn0[0] : vc0[0]; s0[1] = last ? vn0[1] : vc0[1]; s1[0] = last ? vn1[0] : vc1[0]; s1[1] = last ? vn1[1] : vc1[1];
      const char* a3 = a2 + kstep; const char* b3 = b2 + kstep;
      PG8_LDB(B0, 0, 0); PG8_SCHED; PG8_LDA(At, 0, 0); PG8_STAGE(PG8_SA(1, 1), a1, vc1);
      PG8_WAIT_L(8); PG8_BAR; PG8_WAIT_L(0); PG8_MMA(0, 0, At, B0); PG8_BAR; PG8_SCHED;
      PG8_LDB(B1, 0, 1); PG8_STAGE(PG8_SB(0, 0), b2, voffB);
      PG8_BAR; PG8_WAIT_L(0); PG8_MMA(0, 1, At, B1); PG8_BAR;
      PG8_LDA(At, 0, 1); PG8_STAGE(PG8_SA(0, 0), a2, s0);
      PG8_BAR; PG8_WAIT_L(0); PG8_MMA(1, 0, At, B0); PG8_BAR; PG8_SCHED;
      PG8_STAGE(PG8_SB(0, 1), b2 + hstepB, voffB);
      PG8_WAIT_V(6); PG8_BAR; PG8_MMA(1, 1, At, B1); PG8_BAR;
      PG8_LDB(B0, 1, 0); PG8_SCHED; PG8_LDA(At, 1, 0); PG8_STAGE(PG8_SA(0, 1), a2, s1);
      PG8_WAIT_L(8); PG8_BAR; PG8_WAIT_L(0); PG8_MMA(0, 0, At, B0); PG8_BAR; PG8_SCHED;
      PG8_LDB(B1, 1, 1); PG8_STAGE(PG8_SB(1, 0), b3, voffB);
      PG8_BAR; PG8_WAIT_L(0); PG8_MMA(0, 1, At, B1); PG8_BAR;
      PG8_LDA(At, 1, 1); PG8_STAGE(PG8_SA(1, 0), a3, s0);
      PG8_BAR; PG8_WAIT_L(0); PG8_MMA(1, 0, At, B0); PG8_BAR; PG8_SCHED;
      PG8_STAGE(PG8_SB(1, 1), b3 + hstepB, voffB);
      PG8_WAIT_V(6); PG8_BAR; PG8_MMA(1, 1, At, B1); PG8_BAR;
    }
    E(acc, cur, wr, wc, fr, fq);
#if defined(DUP_MASK)
    if (DUP_MASK & 8192) E(acc, cur, wr, wc, fr, fq);
#endif
    if (!has_next) break;
#pragma unroll
    for (int a = 0; a < 2; ++a)
#pragma unroll
      for (int b = 0; b < 2; ++b)
#pragma unroll
        for (int m = 0; m < 4; ++m)
#pragma unroll
          for (int n = 0; n < 2; ++n) acc[a][b][m][n] = (f32x4){0.f, 0.f, 0.f, 0.f};
    cur = nxt; cB = nB; ++ui; vc0[0] = vn0[0]; vc0[1] = vn0[1]; vc1[0] = vn1[0]; vc1[1] = vn1[1];
  }
  PG8_WAIT_V(0);
  if (wr == 0) PG8_BAR;
  PG8_BAR;
#undef PG8_ROWOFF
#undef PG8_SA
#undef PG8_SB
#undef PG8_STAGE
#undef PG8_LDA
#undef PG8_LDB
#undef PG8_MMA
#undef PG8_WAIT_V
#undef PG8_WAIT_L
#undef PG8_BAR
#undef PG8_SCHED
}

struct EpiBf16 {
  static constexpr bool PERM = true;
  bf16_t* O; int ldc;
  __device__ __forceinline__ void operator()(const f32x4 (&acc)[2][2][4][2], const Unit& u, int wr, int wc, int fr, int fq) const {
    const int row0 = u.pm * BM + wr * 64 + fr, col0 = u.pn * BM + wc * 32 + 8 * fq;
#pragma unroll
    for (int ai = 0; ai < 2; ++ai)
#pragma unroll
      for (int m = 0; m < 4; ++m) { bf16_t* rowp = O + (size_t)(row0 + ai * HALF + m * 16) * ldc + col0;
#pragma unroll
        for (int bj = 0; bj < 2; ++bj) { const f32x4 v0 = acc[ai][bj][m][0], v1 = acc[ai][bj][m][1];
          u32x4 w; w.x = cvt_pk_bf16(v0[0], v0[1]); w.y = cvt_pk_bf16(v0[2], v0[3]); w.z = cvt_pk_bf16(v1[0], v1[1]); w.w = cvt_pk_bf16(v1[2], v1[3]);
          *(u32x4*)(rowp + bj * HALF) = w; } }
  }
};
struct EpiYT {
  static constexpr bool PERM = true;
  bf16_t* YT; bf16_t* YTC;
  __device__ __forceinline__ void operator()(const f32x4 (&acc)[2][2][4][2], const Unit& u, int wr, int wc, int fr, int fq) const {
    const bool lat = u.pn < 64;
    const int b = lat ? (u.pn >> 3) : (u.pn - 64);
    const int tb = (lat ? (u.pn & 7) * 256 : 0) + wc * 32 + 8 * fq;
    const int nseq = lat ? 2048 : 256;
    bf16_t* base = lat ? YT : YTC;
#pragma unroll
    for (int ai = 0; ai < 2; ++ai)
#pragma unroll
      for (int m = 0; m < 4; ++m) { const int hl = ai * HALF + wr * 64 + m * 16 + fr;
        bf16_t* rowp = base + (size_t)(b * 256 + hl) * nseq + tb;
#pragma unroll
        for (int bj = 0; bj < 2; ++bj) { const f32x4 v0 = acc[ai][bj][m][0], v1 = acc[ai][bj][m][1];
          u32x4 w; w.x = cvt_pk_bf16(v0[0], v0[1]); w.y = cvt_pk_bf16(v0[2], v0[3]); w.z = cvt_pk_bf16(v1[0], v1[1]); w.w = cvt_pk_bf16(v1[2], v1[3]);
          *(u32x4*)(rowp + bj * HALF) = w; } }
  }
};
struct EpiDft {
  static constexpr bool PERM = true;
  bf16_t* CAT; int tok0, nseq; float scale;
  __device__ __forceinline__ void operator()(const f32x4 (&acc)[2][2][4][2], const Unit& u, int wr, int wc, int fr, int fq) const {
    const int row0 = tok0 + u.pn * nseq + u.pm * BM + wr * 64 + fr, col0 = wc * 32 + 8 * fq;
#pragma unroll
    for (int ai = 0; ai < 2; ++ai)
#pragma unroll
      for (int m = 0; m < 4; ++m) { bf16_t* rowp = CAT + (size_t)(row0 + ai * HALF + m * 16) * 1024 + col0;
#pragma unroll
        for (int bj = 0; bj < 2; ++bj) { const f32x4 v0 = acc[ai][bj][m][0] * scale, v1 = acc[ai][bj][m][1] * scale;
          u32x4 w; w.x = cvt_pk_bf16(v0[0], v0[1]); w.y = cvt_pk_bf16(v0[2], v0[3]); w.z = cvt_pk_bf16(v1[0], v1[1]); w.w = cvt_pk_bf16(v1[2], v1[3]);
          *(u32x4*)(rowp + bj * HALF) = w; } }
  }
};
struct EpiDft2 {
  static constexpr bool PERM = true;
  bf16_t* CAT; float scale;
  __device__ __forceinline__ void operator()(const f32x4 (&acc)[2][2][4][2], const Unit& u, int wr, int wc, int fr, int fq) const {
    const int rowb = (u.pn >> 3) * SEQ + (u.pn & 7), k20 = wr * 64 + fr, col0 = wc * 32 + 8 * fq;
#pragma unroll
    for (int ai = 0; ai < 2; ++ai)
#pragma unroll
      for (int m = 0; m < 4; ++m) { bf16_t* rowp = CAT + (size_t)(rowb + 8 * (k20 + ai * HALF + m * 16)) * 1024 + col0;
#pragma unroll
        for (int bj = 0; bj < 2; ++bj) { const f32x4 v0 = acc[ai][bj][m][0] * scale, v1 = acc[ai][bj][m][1] * scale;
          u32x4 w; w.x = cvt_pk_bf16(v0[0], v0[1]); w.y = cvt_pk_bf16(v0[2], v0[3]); w.z = cvt_pk_bf16(v1[0], v1[1]); w.w = cvt_pk_bf16(v1[2], v1[3]);
          *(u32x4*)(rowp + bj * HALF) = w; } }
  }
};
struct EpiOut {
  static constexpr bool PERM = true;
  const bf16_t* X; bf16_t* XMID; const float* modl;
  __device__ __forceinline__ void operator()(const f32x4 (&acc)[2][2][4][2], const Unit& u, int wr, int wc, int fr, int fq) const {
    const int row0 = u.pm * BM + wr * 64 + fr, col0 = u.pn * BM + wc * 32 + 8 * fq;
    const int s = u.pm < 64 ? (u.pm >> 3) : 8;
    const float* g1 = modl + (size_t)s * 6144 + 2048 + col0;
    f32x4 gv[2][2];
#pragma unroll
    for (int bj = 0; bj < 2; ++bj)
#pragma unroll
      for (int n = 0; n < 2; ++n) gv[bj][n] = *(const f32x4*)(g1 + bj * HALF + n * 4);
#pragma unroll
    for (int ai = 0; ai < 2; ++ai)
#pragma unroll
      for (int m = 0; m < 4; ++m) { const size_t off = (size_t)(row0 + ai * HALF + m * 16) * 1024 + col0;
#pragma unroll
        for (int bj = 0; bj < 2; ++bj) { const u32x4 xw = *(const u32x4*)(X + off + bj * HALF);
          const f32x4 x0 = (f32x4){__uint_as_float(xw.x << 16), __uint_as_float(xw.x & 0xffff0000u), __uint_as_float(xw.y << 16), __uint_as_float(xw.y & 0xffff0000u)};
          const f32x4 x1 = (f32x4){__uint_as_float(xw.z << 16), __uint_as_float(xw.z & 0xffff0000u), __uint_as_float(xw.w << 16), __uint_as_float(xw.w & 0xffff0000u)};
          const f32x4 v0 = x0 + gv[bj][0] * acc[ai][bj][m][0], v1 = x1 + gv[bj][1] * acc[ai][bj][m][1];
          u32x4 w; w.x = cvt_pk_bf16(v0[0], v0[1]); w.y = cvt_pk_bf16(v0[2], v0[3]); w.z = cvt_pk_bf16(v1[0], v1[1]); w.w = cvt_pk_bf16(v1[2], v1[3]);
          *(u32x4*)(XMID + off + bj * HALF) = w; }
        asm volatile("" ::: "memory"); }
  }
};
struct EpiMoe1 {
  static constexpr bool PERM = true;
  bf16_t* HH;
  __device__ __forceinline__ void operator()(const f32x4 (&acc)[2][2][4][2], const Unit& u, int wr, int wc, int fr, int fq) const {
    const int row0 = u.pm * BM + wr * 64 + fr, col0 = (u.pn & 7) * 128 + wc * 32 + 8 * fq;
#pragma unroll
    for (int ai = 0; ai < 2; ++ai)
#pragma unroll
      for (int m = 0; m < 4; ++m) { bf16_t* rowp = HH + (size_t)(row0 + ai * HALF + m * 16) * 1024 + col0;
        float h[8];
#pragma unroll
        for (int n = 0; n < 2; ++n)
#pragma unroll
          for (int j = 0; j < 4; ++j) { const float a = acc[ai][0][m][n][j], uu = acc[ai][1][m][n][j];
            h[n * 4 + j] = a * __builtin_amdgcn_rcpf(1.f + __expf(-a)) * uu; }
        u32x4 w; w.x = cvt_pk_bf16(h[0], h[1]); w.y = cvt_pk_bf16(h[2], h[3]); w.z = cvt_pk_bf16(h[4], h[5]); w.w = cvt_pk_bf16(h[6], h[7]);
        *(u32x4*)rowp = w; }
  }
};
struct EpiMoe2 {
  static constexpr bool PERM = true;
  bf16_t* YY; const float* gate;
  __device__ __forceinline__ void operator()(const f32x4 (&acc)[2][2][4][2], const Unit& u, int wr, int wc, int fr, int fq) const {
    const int row0 = u.pm * BM + wr * 64 + fr, col0 = (u.pn & 3) * BM + wc * 32 + 8 * fq;
#pragma unroll
    for (int ai = 0; ai < 2; ++ai)
#pragma unroll
      for (int m = 0; m < 4; ++m) { const int row = row0 + ai * HALF + m * 16; const float gt = gate[row];
        bf16_t* rowp = YY + (size_t)row * 1024 + col0;
#pragma unroll
        for (int bj = 0; bj < 2; ++bj) { const f32x4 v0 = acc[ai][bj][m][0] * gt, v1 = acc[ai][bj][m][1] * gt;
          u32x4 w; w.x = cvt_pk_bf16(v0[0], v0[1]); w.y = cvt_pk_bf16(v0[2], v0[3]); w.z = cvt_pk_bf16(v1[0], v1[1]); w.w = cvt_pk_bf16(v1[2], v1[3]);
          *(u32x4*)(rowp + bj * HALF) = w; } }
  }
};
}

namespace att {
constexpr int D = 128, QBLK = 32, KVBLK = 64;
constexpr float SCALE = 0.088388347648318440f;
constexpr float THR = 8.f;
constexpr int LDQ = 1280, LDK = 256, LDO = 1024;
constexpr size_t SHM_V = KVBLK * D * 2, SHM_K = KVBLK * D * 2, SHM_ATTN = 2 * SHM_V + 2 * SHM_K + 8 * 64 * 4;
#define KSWZ(row, colB) ((row) * 256 + ((colB) ^ (((row) & 7) << 4)))
#define SBAR() __builtin_amdgcn_sched_barrier(0)
__device__ __forceinline__ int crow(int r, int hi) { return (r & 3) + 8 * (r >> 2) + 4 * hi; }
__device__ __forceinline__ void partialSM(f32x16& p0, f32x16& p1, float& m_reg, float& mn, float& alpha) {
  constexpr float C = SCALE * 1.4426950408889634f;
  float pmax = p0[0];
#pragma unroll
  for (int r = 1; r < 16; ++r) pmax = fmaxf(pmax, p0[r]);
#pragma unroll
  for (int r = 0; r < 16; ++r) pmax = fmaxf(pmax, p1[r]);
  { auto rr = __builtin_amdgcn_permlane32_swap(__float_as_uint(pmax), __float_as_uint(pmax), false, false);
    pmax = fmaxf(__uint_as_float(rr[0]), __uint_as_float(rr[1])); }
  if (__builtin_expect(__all(pmax - m_reg <= THR / SCALE), 1)) { mn = m_reg; alpha = 1.f; }
  else { mn = fmaxf(m_reg, pmax); alpha = __builtin_amdgcn_exp2f((m_reg - mn) * C); m_reg = mn; }
  float mnC = -mn * C;
#pragma unroll
  for (int r = 0; r < 16; ++r) p0[r] = fmaf(p0[r], C, mnC);
#pragma unroll
  for (int r = 0; r < 16; ++r) p1[r] = fmaf(p1[r], C, mnC);
#pragma unroll
  for (int r = 0; r < 16; ++r) p0[r] = __builtin_amdgcn_exp2f(p0[r]);
}
__device__ __forceinline__ void finishSM(f32x16& p0, f32x16& p1, float alpha, float& l_reg, bf16x8& pa0, bf16x8& pa1, bf16x8& pa2, bf16x8& pa3) {
#pragma unroll
  for (int r = 0; r < 16; ++r) p1[r] = __builtin_amdgcn_exp2f(p1[r]);
  float ps = 0;
#pragma unroll
  for (int r = 0; r < 16; ++r) ps += p0[r];
#pragma unroll
  for (int r = 0; r < 16; ++r) ps += p1[r];
  { auto rr = __builtin_amdgcn_permlane32_swap(__float_as_uint(ps), __float_as_uint(ps), false, false);
    ps = __uint_as_float(rr[0]) + __uint_as_float(rr[1]); }
  l_reg = l_reg * alpha + ps;
#define PK4(P, BASE, OUT) do { unsigned a0 = cvt_pk_bf16(P[BASE + 0], P[BASE + 1]), a1 = cvt_pk_bf16(P[BASE + 2], P[BASE + 3]);   \
    unsigned b0 = cvt_pk_bf16(P[BASE + 4], P[BASE + 5]), b1 = cvt_pk_bf16(P[BASE + 6], P[BASE + 7]);                              \
    auto r0 = __builtin_amdgcn_permlane32_swap(a0, b0, false, false); auto r1 = __builtin_amdgcn_permlane32_swap(a1, b1, false, false); \
    u32x4 w = {r0[0], r1[0], r0[1], r1[1]}; OUT = *reinterpret_cast<bf16x8*>(&w); } while (0)
  PK4(p0, 0, pa0); PK4(p0, 8, pa1); PK4(p1, 0, pa2); PK4(p1, 8, pa3);
#undef PK4
}
__device__ __forceinline__ void qkt(f32x16& p0, f32x16& p1, const bf16_t* Ks, const bf16x8* qr, int r32, int hi) {
  p0 = f32x16{}; p1 = f32x16{};
#pragma unroll
  for (int d0 = 0; d0 < 8; ++d0) { int cb = (d0 * 16 + hi * 8) * 2;
    bf16x8 b0 = *reinterpret_cast<const bf16x8*>((const char*)Ks + KSWZ(r32, cb));
    bf16x8 b1 = *reinterpret_cast<const bf16x8*>((const char*)Ks + KSWZ(32 + r32, cb));
    p0 = __builtin_amdgcn_mfma_f32_32x32x16_bf16(b0, qr[d0], p0, 0, 0, 0);
    p1 = __builtin_amdgcn_mfma_f32_32x32x16_bf16(b1, qr[d0], p1, 0, 0, 0); }
}
__device__ __forceinline__ int v_st(int k, int c) { const int kk = (k & ~0xC) | ((k & 4) << 1) | ((k & 8) >> 1); return ((kk >> 3) * 4 + (c >> 5)) * 512 + ((kk & 7) * 32 + (c & 31)) * 2; }
__device__ __forceinline__ int v_rd_base(int lane) { return ((lane & 3) << 3) | (((lane >> 2) & 3) << 6) | (((lane >> 4) & 1) << 5) | (((lane >> 5) & 1) << 8); }
constexpr int v_rd_off(int d0, int ks, int half) { return d0 * 512 + ks * 4096 + half * 2048; }
template <int OFF> __device__ __forceinline__ s16x4 tr_read(int vb) {
  s16x4 r; asm volatile("ds_read_b64_tr_b16 %0, %1 offset:%2" : "=&v"(r) : "v"(vb), "i"(OFF) : "memory"); return r;
}
template <int D0> __device__ __forceinline__ void pv_one(f32x16& od, int vb, bf16x8 pa0, bf16x8 pa1, bf16x8 pa2, bf16x8 pa3) {
  const s16x4 l0 = tr_read<v_rd_off(D0, 0, 0)>(vb), h0 = tr_read<v_rd_off(D0, 0, 1)>(vb), l1 = tr_read<v_rd_off(D0, 1, 0)>(vb), h1 = tr_read<v_rd_off(D0, 1, 1)>(vb);
  const s16x4 l2 = tr_read<v_rd_off(D0, 2, 0)>(vb), h2 = tr_read<v_rd_off(D0, 2, 1)>(vb), l3 = tr_read<v_rd_off(D0, 3, 0)>(vb), h3 = tr_read<v_rd_off(D0, 3, 1)>(vb);
  asm volatile("s_waitcnt lgkmcnt(0)" ::: "memory"); SBAR();
#define PK(L, H) (bf16x8){L[0], L[1], L[2], L[3], H[0], H[1], H[2], H[3]}
  od = __builtin_amdgcn_mfma_f32_32x32x16_bf16(pa0, PK(l0, h0), od, 0, 0, 0);
  od = __builtin_amdgcn_mfma_f32_32x32x16_bf16(pa1, PK(l1, h1), od, 0, 0, 0);
  od = __builtin_amdgcn_mfma_f32_32x32x16_bf16(pa2, PK(l2, h2), od, 0, 0, 0);
  od = __builtin_amdgcn_mfma_f32_32x32x16_bf16(pa3, PK(l3, h3), od, 0, 0, 0);
#undef PK
}
__device__ __forceinline__ void pv_d0(f32x16* o, int vb, bf16x8 pa0, bf16x8 pa1, bf16x8 pa2, bf16x8 pa3) {
  pv_one<0>(o[0], vb, pa0, pa1, pa2, pa3); pv_one<1>(o[1], vb, pa0, pa1, pa2, pa3); pv_one<2>(o[2], vb, pa0, pa1, pa2, pa3); pv_one<3>(o[3], vb, pa0, pa1, pa2, pa3);
}
__device__ __forceinline__ void attn_dense_body(const bf16_t* __restrict__ Qb, const bf16_t* __restrict__ Kh, const bf16_t* __restrict__ Vh,
                                                bf16_t* __restrict__ Ob, int seq, char* lds, const float* __restrict__ qg, const float* __restrict__ RC, const float* __restrict__ RS, const bool rope, const int tpos) {
  const int tid = opaque_tid(), wid = tid >> 6, lane = tid & 63, r32 = lane & 31, hi = lane >> 5;
  bf16_t* V_lds = (bf16_t*)lds; bf16_t* K_lds = (bf16_t*)(lds + 2 * SHM_V);
  float* wsl = (float*)(lds + 2 * SHM_V + 2 * SHM_K) + wid * 64; float* li_l = wsl; float* al_l = wsl + 32;
  float m_reg = -1e30f, l_reg = 0; f32x16 o[4] = {}; bf16x8 qr[8];
  const bf16_t* Qw = Qb + (long)(wid * QBLK + r32) * LDQ + hi * 8;
  { float f[8][8]; float ss = 0.f;
#pragma unroll
    for (int d0 = 0; d0 < 8; ++d0) { const u32x4 w = *reinterpret_cast<const u32x4*>(Qw + d0 * 16);
      f[d0][0] = __uint_as_float(w.x << 16); f[d0][1] = __uint_as_float(w.x & 0xffff0000u); f[d0][2] = __uint_as_float(w.y << 16); f[d0][3] = __uint_as_float(w.y & 0xffff0000u);
      f[d0][4] = __uint_as_float(w.z << 16); f[d0][5] = __uint_as_float(w.z & 0xffff0000u); f[d0][6] = __uint_as_float(w.w << 16); f[d0][7] = __uint_as_float(w.w & 0xffff0000u);
#pragma unroll
      for (int j = 0; j < 8; ++j) ss += f[d0][j] * f[d0][j]; }
    ss += __shfl_xor(ss, 32);
    const float rn = rsqrtf(ss * (1.f / 128.f) + EPS);
#pragma unroll
    for (int d0 = 0; d0 < 8; ++d0) { const f32x4 g0 = *(const f32x4*)(qg + d0 * 16 + hi * 8), g1 = *(const f32x4*)(qg + d0 * 16 + hi * 8 + 4);
#pragma unroll
      for (int j = 0; j < 4; ++j) { f[d0][j] *= rn * g0[j]; f[d0][4 + j] *= rn * g1[j]; } }
    if (rope) { const int t = tpos + wid * QBLK + r32;
#pragma unroll
      for (int blk = 0; blk < 2; ++blk) { const int pos = blk ? (t & 63) : (t >> 6);
#pragma unroll
        for (int q = 0; q < 2; ++q) { const int o = pos * 32 + q * 16 + hi * 8;
          const f32x4 c0 = *(const f32x4*)(RC + o), c1 = *(const f32x4*)(RC + o + 4), s0 = *(const f32x4*)(RS + o), s1 = *(const f32x4*)(RS + o + 4);
#pragma unroll
          for (int j = 0; j < 8; ++j) { const float cs = j < 4 ? c0[j & 3] : c1[j & 3], sn = j < 4 ? s0[j & 3] : s1[j & 3];
            const float x1 = f[4 * blk + q][j], x2 = f[4 * blk + q + 2][j]; f[4 * blk + q][j] = x1 * cs - x2 * sn; f[4 * blk + q + 2][j] = x2 * cs + x1 * sn; } } } }
#pragma unroll
    for (int d0 = 0; d0 < 8; ++d0) { u32x4 w; w.x = cvt_pk_bf16(f[d0][0], f[d0][1]); w.y = cvt_pk_bf16(f[d0][2], f[d0][3]); w.z = cvt_pk_bf16(f[d0][4], f[d0][5]); w.w = cvt_pk_bf16(f[d0][6], f[d0][7]);
      qr[d0] = *reinterpret_cast<bf16x8*>(&w); } }
  const int sr = tid >> 4, sc = (tid & 15) * 8, vst0 = v_st(sr, sc), vst1 = v_st(32 + sr, sc);
  const int vb0 = (int)(uintptr_t)V_lds + v_rd_base(lane);
  struct { bf16x8 vs0, vs1, ks0, ks1; } sr_[2];
#define SLOAD(i, k0) do { sr_[i].vs0 = *reinterpret_cast<const bf16x8*>(&Vh[(long)((k0) + sr) * LDK + sc]); sr_[i].vs1 = *reinterpret_cast<const bf16x8*>(&Vh[(long)((k0) + 32 + sr) * LDK + sc]); \
    sr_[i].ks0 = *reinterpret_cast<const bf16x8*>(&Kh[(long)((k0) + sr) * LDK + sc]); sr_[i].ks1 = *reinterpret_cast<const bf16x8*>(&Kh[(long)((k0) + 32 + sr) * LDK + sc]); } while (0)
#define SWRITE(b, i) do { *(bf16x8*)((char*)V_lds + (b) * SHM_V + vst0) = sr_[i].vs0;          \
    *(bf16x8*)((char*)V_lds + (b) * SHM_V + vst1) = sr_[i].vs1; int kc = sc * 2;               \
    *(bf16x8*)((char*)K_lds + (b) * SHM_K + KSWZ(sr, kc)) = sr_[i].ks0;                       \
    *(bf16x8*)((char*)K_lds + (b) * SHM_K + KSWZ(32 + sr, kc)) = sr_[i].ks1; } while (0)
#define SWAIT() asm volatile("s_waitcnt vmcnt(4)" ::: "memory")
#define RESC(a) do { if (__any((a) < 1.f)) { if (hi == 0) al_l[r32] = (a); asm volatile("s_waitcnt lgkmcnt(0)" ::: "memory"); \
    _Pragma("unroll") for (int d = 0; d < 4; ++d) _Pragma("unroll") for (int r = 0; r < 16; ++r) o[d][r] *= al_l[crow(r, hi)]; } } while (0)
  f32x16 pA0, pA1, pB0, pB1; float mnA, mnB, alA, alB; bf16x8 pa0, pa1, pa2, pa3; const int NT = seq / KVBLK;
  constexpr int SE = 0, SO = 1;
  SLOAD(SE, 0); asm volatile("s_waitcnt vmcnt(0)" ::: "memory"); SWRITE(0, SE); __syncthreads();
  qkt(pA0, pA1, K_lds, qr, r32, hi); partialSM(pA0, pA1, m_reg, mnA, alA);
  SLOAD(SO, KVBLK); if (2 < NT) SLOAD(SE, 2 * KVBLK);
  SWAIT(); SWRITE(1, SO); __syncthreads();
  for (int j = 1; j + 1 < NT; j += 2) {
    SBAR(); qkt(pB0, pB1, (bf16_t*)((char*)K_lds + SHM_K), qr, r32, hi);
    finishSM(pA0, pA1, alA, l_reg, pa0, pa1, pa2, pa3); SBAR();
    SLOAD(SO, (j + 2) * KVBLK); SBAR();
    pv_d0(o, vb0, pa0, pa1, pa2, pa3); partialSM(pB0, pB1, m_reg, mnB, alB);
    __syncthreads(); SWAIT(); SWRITE(0, SE);
    RESC(alB); __syncthreads();
    SBAR(); qkt(pA0, pA1, K_lds, qr, r32, hi);
    finishSM(pB0, pB1, alB, l_reg, pa0, pa1, pa2, pa3); SBAR();
    if (j + 3 < NT) SLOAD(SE, (j + 3) * KVBLK); SBAR();
    pv_d0(o, vb0 + (int)SHM_V, pa0, pa1, pa2, pa3); partialSM(pA0, pA1, m_reg, mnA, alA);
    __syncthreads(); SWAIT(); SWRITE(1, SO);
    RESC(alA); __syncthreads();
  }
  SBAR(); qkt(pB0, pB1, (bf16_t*)((char*)K_lds + SHM_K), qr, r32, hi);
  finishSM(pA0, pA1, alA, l_reg, pa0, pa1, pa2, pa3); SBAR();
  pv_d0(o, vb0, pa0, pa1, pa2, pa3); partialSM(pB0, pB1, m_reg, mnB, alB);
  __syncthreads(); RESC(alB);
  finishSM(pB0, pB1, alB, l_reg, pa0, pa1, pa2, pa3); SBAR();
  pv_d0(o, vb0 + (int)SHM_V, pa0, pa1, pa2, pa3);
  if (hi == 0) li_l[r32] = l_reg; asm volatile("s_waitcnt lgkmcnt(0)" ::: "memory");
  float rli[16];
#pragma unroll
  for (int r = 0; r < 16; ++r) rli[r] = __builtin_amdgcn_rcpf(li_l[crow(r, hi)]);
  bf16_t* Ow = Ob + (long)(wid * QBLK) * LDO;
#pragma unroll
  for (int r = 0; r < 16; ++r) { int orow = crow(r, hi);
#pragma unroll
    for (int d0 = 0; d0 < 4; ++d0) Ow[(long)orow * LDO + d0 * 32 + r32] = f2bf(o[d0][r] * rli[r]); }
  __syncthreads();
#undef SLOAD
#undef SWRITE
#undef SWAIT
#undef RESC
}
}

__device__ __forceinline__ void transpose_item(const float* W, int ldw, int k0, int n0, bf16_t* dst, int dld, int drow0, int dcol0, LAS float* scr, int lane) {
  const int kq = lane >> 3, n4 = (lane & 7) * 4;
  f32x4 v[8];
#pragma unroll
  for (int i = 0; i < 8; ++i) v[i] = __builtin_nontemporal_load((const f32x4*)(W + (size_t)(k0 + i * 8 + kq) * ldw + n0 + n4));
#pragma unroll
  for (int i = 0; i < 8; ++i) { LAS float* d = scr + (i * 8 + kq) * 33 + n4; d[0] = v[i][0]; d[1] = v[i][1]; d[2] = v[i][2]; d[3] = v[i][3]; }
  LDS_WAIT();
  const int c = lane & 7;
#pragma unroll
  for (int j = 0; j < 4; ++j) { const int n = (lane >> 3) + 8 * j; const LAS float* s = scr + (8 * c) * 33 + n;
    u32x4 o; o.x = cvt_pk_bf16(s[0 * 33], s[1 * 33]); o.y = cvt_pk_bf16(s[2 * 33], s[3 * 33]); o.z = cvt_pk_bf16(s[4 * 33], s[5 * 33]); o.w = cvt_pk_bf16(s[6 * 33], s[7 * 33]);
    *(u32x4*)(dst + (size_t)(drow0 + n) * dld + dcol0 + 8 * c) = o; }
  LDS_WAIT();
}

__device__ __forceinline__ void convert_moe_weights(int l, int rank, int nranks, int lo, int hi, LAS unsigned char* lds);
__device__ __forceinline__ void ph_prep(LAS unsigned char* lds) {
  CParams& p = *kargs();
  unsigned char* ws = p.ws;
  const int tid = opaque_tid(), lane = tid & 63, wave = tid >> 6, G = gridDim.x, bx = blockIdx.x;
#ifndef PREP_MASK
#define PREP_MASK 63
#endif
  if (PREP_MASK & 1) {
    LAS float* sc = (LAS float*)lds;
    LAS float* red = (LAS float*)(lds + 9 * 1024 * 4);
    for (int i = tid; i < 9 * 1024; i += NTHR) { const int s = i >> 10, k = i & 1023; const float v = s < 8 ? p.in[I_C][s * 1024 + k] : p.in[I_CCTX][k];
      sc[i] = v / (1.f + __expf(-v)); }
    __syncthreads();
    float* MOD = (float*)(ws + WS_MOD);
    typedef float f32x2v __attribute__((ext_vector_type(2)));
    for (int item = bx; item < 4 * 48; item += G) {
      const int l = item / 48, n0 = (item % 48) * 128;
      const float* w = p.in[I_ADAW] + (size_t)l * 1024 * 6144 + (size_t)(wave * 128) * 6144 + n0 + lane * 2;
      float acc[9][2];
#pragma unroll
      for (int s = 0; s < 9; ++s) { acc[s][0] = 0.f; acc[s][1] = 0.f; }
#pragma unroll 32
      for (int k = 0; k < 128; ++k) { const f32x2v wv = __builtin_nontemporal_load((const f32x2v*)(w + (size_t)k * 6144));
#pragma unroll
        for (int s = 0; s < 9; ++s) { const float a = sc[s * 1024 + wave * 128 + k]; acc[s][0] += a * wv.x; acc[s][1] += a * wv.y; } }
#pragma unroll
      for (int s = 0; s < 9; ++s) { red[(wave * 9 + s) * 128 + lane * 2] = acc[s][0]; red[(wave * 9 + s) * 128 + lane * 2 + 1] = acc[s][1]; }
      __syncthreads();
      for (int o = tid; o < 9 * 128; o += NTHR) { const int s = o >> 7, ln = o & 127; float t = 0.f;
#pragma unroll
        for (int ks = 0; ks < 8; ++ks) t += red[(ks * 9 + s) * 128 + ln];
        MOD[((size_t)l * 9 + s) * 6144 + n0 + ln] = t + p.in[I_ADAB][l * 6144 + n0 + ln]; }
      __syncthreads();
    }
    if (G == 256 && bx >= 192) convert_moe_weights(0, bx - 192, 64, 0, CONV_P, lds);
  }
  if ((PREP_MASK & 2) && bx == 0) {
    float* RC = (float*)(ws + WS_ROPE); float* RS = RC + 2048;
    for (int i = tid; i < 2048; i += NTHR) { const int pos = i >> 5, fi = i & 31;
      const float inv = exp2f(-(float)fi * (13.287712379549449f / 32.f));
      const float ang = (float)pos * inv;
      const double a = (double)ang; const double kk = rint(a * 0.15915494309189535); const float r = (float)(a - kk * 6.283185307179586);
      RC[i] = __cosf(r); RS[i] = __sinf(r); }
  }
  if (PREP_MASK & 4) {
    LAS float* tab = (LAS float*)(lds + 64 * 1024);
    for (int i = tid; i < 2048; i += NTHR) { const int m = i < 1024 ? i : i - 2048; tab[i] = __cosf((float)m * (6.283185307179586f / 2048.f)); }
    __syncthreads();
    bf16_t* DFTM = (bf16_t*)(ws + WS_DFTM);
    for (int it = bx * NTHR + tid; it < 256 * 512 / 8; it += G * NTHR) {
      const int k = it >> 6, j0 = (it & 63) * 8; unsigned w[4];
#pragma unroll
      for (int q = 0; q < 4; ++q) { float v[2];
#pragma unroll
        for (int h = 0; h < 2; ++h) { const int j = j0 + q * 2 + h; v[h] = j < 256 ? tab[(8 * k * j) & 2047] : -tab[(8 * k * (j - 256) + 512) & 2047]; }
        w[q] = cvt_pk_bf16(v[0], v[1]); }
      *(u32x4*)(DFTM + (size_t)it * 8) = (u32x4){w[0], w[1], w[2], w[3]};
    }
    bf16_t* DFTC = (bf16_t*)(ws + WS_DFTC);
    for (int it = bx * NTHR + tid; it < 256 * 256 / 8; it += G * NTHR) {
      const int k = it >> 5, j0 = (it & 31) * 8; unsigned w[4];
#pragma unroll
      for (int q = 0; q < 4; ++q) { float v[2];
#pragma unroll
        for (int h = 0; h < 2; ++h) { const int j = j0 + q * 2 + h; const int idx = j <= 128 ? (8 * k * j) & 2047 : (8 * k * (j - 128) + 512) & 2047; v[h] = tab[idx]; }
        w[q] = cvt_pk_bf16(v[0], v[1]); }
      *(u32x4*)(DFTC + (size_t)it * 8) = (u32x4){w[0], w[1], w[2], w[3]};
    }
    __syncthreads();
  }
  if (PREP_MASK & 8) {
    LAS float* Wt = (LAS float*)lds;
    LAS float* T = (LAS float*)(lds + 64 * 65 * 4);
    bf16_t* WF = (bf16_t*)(ws + WS_WF);
    for (int item = bx; item < 4 * 4 * 16; item += G) {
      const int l = item >> 6, h = (item >> 4) & 3, kc = item & 15;
      if (tid < 64) { T[tid] = __cosf((float)(tid < 32 ? tid : tid - 64) * (6.283185307179586f / 64.f)); T[64 + tid] = __sinf((float)(tid < 32 ? tid : tid - 64) * (6.283185307179586f / 64.f)); }
      { float tv[8];
#pragma unroll
        for (int q = 0; q < 8; ++q) { const int i = tid + q * NTHR, kk = i >> 6, c = i & 63; tv[q] = p.in[I_WIN][(size_t)l * 1024 * 1536 + (size_t)(kc * 64 + kk) * 1536 + h * 64 + c]; }
#pragma unroll
        for (int q = 0; q < 8; ++q) { const int i = tid + q * NTHR, kk = i >> 6, c = i & 63; Wt[kk * 65 + c] = tv[q]; } }
      __syncthreads();
      float wrow[64];
#pragma unroll
      for (int c = 0; c < 64; ++c) wrow[c] = Wt[lane * 65 + c];
#pragma unroll 1
      for (int jj = 0; jj < 8; ++jj) { const int jp = wave * 8 + jj, cs = jp >= 33 ? 1 : 0, lq = cs ? jp - 32 : jp; float a = 0.f;
        asm volatile("" ::: "memory");
#pragma unroll
        for (int c = 0; c < 64; ++c) a += wrow[c] * T[cs * 64 + ((lq * c) & 63)];
        WF[((size_t)l * 256 + h * 64 + jp) * 1024 + kc * 64 + lane] = f2bf(a); }
      __syncthreads();
    }
  }
  if (PREP_MASK & 16) {
    LAS float* As = (LAS float*)lds;
    LAS float* Bs = (LAS float*)(lds + 64 * 256 * 4);
    bf16_t* WO = (bf16_t*)(ws + WS_WO);
    for (int item = bx; item < 4 * 8 * 16; item += G) {
      const int l = item >> 7, kt = (item >> 4) & 7, ntile = item & 15;
      const int M = kt < 4 ? 256 : 64;
      const float* wout = p.in[I_WOUT] + (size_t)l * 1024 * 1024;
      if (kt < 4) {
        const float* wf = p.in[I_WFOU] + (size_t)l * 256 * 256 + (size_t)(kt * 64) * 256;
        { f32x4 ta[8], tb[8];
#pragma unroll
          for (int q = 0; q < 8; ++q) { const int i = tid + q * NTHR; ta[q] = *(const f32x4*)(wf + i * 4); const int m = i >> 4, n4 = (i & 15) * 4; tb[q] = *(const f32x4*)(wout + (size_t)m * 1024 + ntile * 64 + n4); }
#pragma unroll
          for (int q = 0; q < 8; ++q) { const int i = tid + q * NTHR; *(LAS f32x4*)(As + i * 4) = ta[q]; *(LAS f32x4*)(Bs + i * 4) = tb[q]; } }
      } else {
        const int g = kt - 4;
        const float* wp = p.in[I_WPOOL] + (size_t)l * 4 * 64 * 64 + (size_t)g * 64 * 64;
        const float* ps = p.in[I_PSCALE] + l * 256 + g * 64;
        { f32x4 ta[2], tb[2], tp[2];
#pragma unroll
          for (int q = 0; q < 2; ++q) { const int i = tid + q * NTHR; ta[q] = *(const f32x4*)(wp + i * 4); tp[q] = *(const f32x4*)(ps + (i & 15) * 4); const int m = i >> 4, n4 = (i & 15) * 4; tb[q] = *(const f32x4*)(wout + (size_t)(256 + g * 64 + m) * 1024 + ntile * 64 + n4); }
#pragma unroll
          for (int q = 0; q < 2; ++q) { const int i = tid + q * NTHR; *(LAS f32x4*)(As + i * 4) = ta[q] * tp[q]; *(LAS f32x4*)(Bs + i * 4) = tb[q]; } }
      }
      __syncthreads();
      float acc[8];
#pragma unroll
      for (int i = 0; i < 8; ++i) acc[i] = 0.f;
      for (int m = 0; m < M; m += 4) {
        const float b0 = Bs[(m + 0) * 64 + lane], b1 = Bs[(m + 1) * 64 + lane], b2 = Bs[(m + 2) * 64 + lane], b3 = Bs[(m + 3) * 64 + lane];
#pragma unroll
        for (int i = 0; i < 8; ++i) { const f32x4 a = *(const LAS f32x4*)(As + (wave * 8 + i) * M + m); acc[i] += a[0] * b0 + a[1] * b1 + a[2] * b2 + a[3] * b3; }
      }
      u32x4 o; o.x = cvt_pk_bf16(acc[0], acc[1]); o.y = cvt_pk_bf16(acc[2], acc[3]); o.z = cvt_pk_bf16(acc[4], acc[5]); o.w = cvt_pk_bf16(acc[6], acc[7]);
      *(u32x4*)(WO + ((size_t)l * 1024 + ntile * 64 + lane) * 1024 + kt * 64 + wave * 8) = o;
      __syncthreads();
    }
  }
  if (PREP_MASK & 32) {
    LAS float* scr = (LAS float*)(lds + wave * (64 * 33 * 4));
    constexpr int PER_L = 640 + 256;
    const int gw = bx * NWAVE + wave, NGW = G * NWAVE;
    for (int it = gw; it < 4 * PER_L; it += NGW) {
      const int l = it / PER_L; int r = it % PER_L;
      if (r < 640) { const int kb = r / 40, nb = r % 40;
        transpose_item(p.in[I_WIN] + (size_t)l * 1024 * 1536 + 256, 1536, kb * 64, nb * 32, (bf16_t*)(ws + WS_WP) + (size_t)l * 1280 * 1024, 1024, nb * 32, kb * 64, scr, lane); continue; }
      r -= 640;
      { const int kb = r >> 5, nb = r & 31;
        transpose_item(p.in[I_WOUT] + (size_t)l * 1024 * 1024 + (size_t)512 * 1024, 1024, kb * 64, nb * 32, (bf16_t*)(ws + WS_WO) + (size_t)l * 1024 * 1024, 1024, nb * 32, 512 + kb * 64, scr, lane); }
    }
  }
  __syncthreads();
}

__device__ __forceinline__ void moe_item_addr(CParams& p, unsigned char* ws, int l, int r, const float*& src, bf16_t*& dst, int& k0, int& n0, int& drow0) {
  const int e = r / 1536, q = r % 1536, mat = q >> 9, item = q & 511, kb = item >> 5, nb = item & 31;
  n0 = nb * 32; k0 = kb * 64;
  const size_t eoff = (size_t)e * 1024 * 1024, goff = ((size_t)l * 16 + e) * 1024 * 1024;
  if (mat == 2) { src = p.in[I_WDOWN] + goff; dst = (bf16_t*)(ws + ((l & 1) ? WS_WD2 : WS_WD)) + eoff; drow0 = n0; }
  else { src = (mat ? p.in[I_WUP] : p.in[I_WGATE]) + goff; dst = (bf16_t*)(ws + ((l & 1) ? WS_WGU2 : WS_WGU)) + eoff * 2; drow0 = (n0 >> 7) * 256 + mat * 128 + (n0 & 127); }
}
__device__ __forceinline__ void convert_moe_weights(int l, int rank, int nranks, int lo, int hi, LAS unsigned char* lds) {
  CParams& p = *kargs();
  unsigned char* ws = p.ws;
  const int tid = opaque_tid(), lane = tid & 63, wave = tid >> 6;
  LAS float* scr = (LAS float*)(lds + wave * (64 * 33 * 4));
  const int kq = lane >> 3, n4 = (lane & 7) * 4, c = lane & 7;
  const int step = nranks * NWAVE;
  int r = lo + rank * NWAVE + wave;
  f32x4 v[8];
  const float* src; bf16_t* dst; int k0, n0, drow0;
  if (r < hi) { moe_item_addr(p, ws, l, r, src, dst, k0, n0, drow0);
#pragma unroll
    for (int i = 0; i < 8; ++i) v[i] = __builtin_nontemporal_load((const f32x4*)(src + (size_t)(k0 + i * 8 + kq) * 1024 + n0 + n4)); }
  while (r < hi) {
    const int rn = r + step;
    f32x4 vn[8]; const float* srcn; bf16_t* dstn = dst; int k0n = k0, n0n = n0, drow0n = drow0;
    if (rn < hi) { moe_item_addr(p, ws, l, rn, srcn, dstn, k0n, n0n, drow0n);
#pragma unroll
      for (int i = 0; i < 8; ++i) vn[i] = __builtin_nontemporal_load((const f32x4*)(srcn + (size_t)(k0n + i * 8 + kq) * 1024 + n0n + n4)); }
    else {
#pragma unroll
      for (int i = 0; i < 8; ++i) vn[i] = v[i]; }
#pragma unroll
    for (int i = 0; i < 8; ++i) { LAS float* d = scr + (i * 8 + kq) * 33 + n4; d[0] = v[i][0]; d[1] = v[i][1]; d[2] = v[i][2]; d[3] = v[i][3]; }
    LDS_WAIT();
#pragma unroll
    for (int j = 0; j < 4; ++j) { const int n = (lane >> 3) + 8 * j; const LAS float* s = scr + (8 * c) * 33 + n;
      u32x4 o; o.x = cvt_pk_bf16(s[0 * 33], s[1 * 33]); o.y = cvt_pk_bf16(s[2 * 33], s[3 * 33]); o.z = cvt_pk_bf16(s[4 * 33], s[5 * 33]); o.w = cvt_pk_bf16(s[6 * 33], s[7 * 33]);
      *(u32x4*)(dst + (size_t)(drow0 + n) * 1024 + k0 + 8 * c) = o; }
    LDS_WAIT();
#pragma unroll
    for (int i = 0; i < 8; ++i) v[i] = vn[i];
    r = rn; dst = dstn; k0 = k0n; n0 = n0n; drow0 = drow0n;
  }
  __syncthreads();
}

__device__ __forceinline__ void moe_combine2(const int* slotrow, const bf16_t* YY, int lane, f32x4 (&a)[2][4]) {
  const int smA = lane < 16 ? slotrow[lane] : -1, smB = lane < 16 ? slotrow[16 + lane] : -1;
  unsigned mA = (unsigned)__ballot(smA >= 0), mB = (unsigned)__ballot(smB >= 0);
#pragma unroll
  for (int u = 0; u < 2; ++u)
#pragma unroll
    for (int j = 0; j < 4; ++j) a[u][j] = (f32x4){0.f, 0.f, 0.f, 0.f};
  while (mA | mB) {
    const int eA = mA ? __builtin_ctz(mA) : 0, eB = mB ? __builtin_ctz(mB) : 0;
    const bool hA = mA != 0u, hB = mB != 0u;
    mA &= mA - 1u; mB &= mB - 1u;
    const int yA = hA ? __shfl(smA, eA) : 0, yB = hB ? __shfl(smB, eB) : 0;
    const bf16_t* pA = YY + (size_t)yA * 1024 + lane * 4; const bf16_t* pB = YY + (size_t)yB * 1024 + lane * 4;
    u32x2 wA[4], wB[4];
#pragma unroll
    for (int j = 0; j < 4; ++j) { wA[j] = *(const u32x2*)(pA + 256 * j); wB[j] = *(const u32x2*)(pB + 256 * j); }
    const float fA = hA ? 1.f : 0.f, fB = hB ? 1.f : 0.f;
#pragma unroll
    for (int j = 0; j < 4; ++j) {
      a[0][j][0] += fA * __uint_as_float(wA[j].x << 16); a[0][j][1] += fA * __uint_as_float(wA[j].x & 0xffff0000u); a[0][j][2] += fA * __uint_as_float(wA[j].y << 16); a[0][j][3] += fA * __uint_as_float(wA[j].y & 0xffff0000u);
      a[1][j][0] += fB * __uint_as_float(wB[j].x << 16); a[1][j][1] += fB * __uint_as_float(wB[j].x & 0xffff0000u); a[1][j][2] += fB * __uint_as_float(wB[j].y << 16); a[1][j][3] += fB * __uint_as_float(wB[j].y & 0xffff0000u); }
  }
}

__device__ __forceinline__ void ph_mod1(int l) {
  CParams& p = *kargs();
  unsigned char* ws = p.ws;
  const int tid = opaque_tid(), lane = tid & 63, wave = tid >> 6;
  const int gw = blockIdx.x * NWAVE + wave, NGW = gridDim.x * NWAVE;
  const float* MOD = (const float*)(ws + WS_MOD);
  bf16_t* X = (bf16_t*)(ws + WS_X); const bf16_t* XMID = (const bf16_t*)(ws + WS_XMID); bf16_t* HX = (bf16_t*)(ws + WS_HX);
  const int* SLOT = (const int*)(ws + WS_SLOT); const bf16_t* YY = (const bf16_t*)(ws + WS_XS);
  const float* ng = p.in[I_N1G] + l * 1024;
  for (int pr = gw; pr < NTOK / 2; pr += NGW) {
    const int row0 = pr * 2;
    const int s = row0 < NLAT ? row0 >> 11 : 8;
    f32x4 v[2][4];
    if (l == 0) {
#pragma unroll
      for (int u = 0; u < 2; ++u) { const int row = row0 + u; const float* src = row < NLAT ? p.in[I_X] + (size_t)row * 1024 : p.in[I_CTX] + (size_t)(row - NLAT) * 1024;
#pragma unroll
        for (int j = 0; j < 4; ++j) v[u][j] = *(const f32x4*)(src + lane * 4 + 256 * j); }
    } else {
#pragma unroll
      for (int u = 0; u < 2; ++u)
#pragma unroll
        for (int j = 0; j < 4; ++j) v[u][j] = ld4bf(XMID + (size_t)(row0 + u) * 1024 + lane * 4 + 256 * j);
      f32x4 a[2][4]; moe_combine2(SLOT + (size_t)row0 * 16, YY, lane, a);
      const float* g2 = MOD + ((size_t)(l - 1) * 9 + s) * 6144 + 5120;
#pragma unroll
      for (int j = 0; j < 4; ++j) { const f32x4 g = *(const f32x4*)(g2 + lane * 4 + 256 * j); v[0][j] += g * a[0][j]; v[1][j] += g * a[1][j]; }
    }
    const float* ml = MOD + ((size_t)l * 9 + s) * 6144;
#pragma unroll
    for (int u = 0; u < 2; ++u) { const int row = row0 + u;
      float ss = 0.f;
#pragma unroll
      for (int j = 0; j < 4; ++j) { st4bf(X + (size_t)row * 1024 + lane * 4 + 256 * j, v[u][j]); ss += v[u][j][0] * v[u][j][0] + v[u][j][1] * v[u][j][1] + v[u][j][2] * v[u][j][2] + v[u][j][3] * v[u][j][3]; }
      const float r = rsqrtf(wave_sum(ss) * (1.f / 1024.f) + EPS);
#pragma unroll
      for (int j = 0; j < 4; ++j) { const int c = lane * 4 + 256 * j;
        const f32x4 g = *(const f32x4*)(ng + c), sh = *(const f32x4*)(ml + c), scl = *(const f32x4*)(ml + 1024 + c);
        const f32x4 y = v[u][j] * r * g * (scl + 1.f) + sh;
        u32x2 w; w.x = cvt_pk_bf16(y[0], y[1]); w.y = cvt_pk_bf16(y[2], y[3]);
        *(u32x2*)(HX + (size_t)row * 1024 + c) = w; } }
  }
}

__device__ __forceinline__ void ph_final() {
  CParams& p = *kargs();
  unsigned char* ws = p.ws;
  const int tid = opaque_tid(), lane = tid & 63, wave = tid >> 6;
  const int gw = blockIdx.x * NWAVE + wave, NGW = gridDim.x * NWAVE;
  const float* MOD = (const float*)(ws + WS_MOD); const bf16_t* XMID = (const bf16_t*)(ws + WS_XMID);
  const int* SLOT = (const int*)(ws + WS_SLOT); const bf16_t* YY = (const bf16_t*)(ws + WS_XS);
  for (int pr = gw; pr < NLAT / 2; pr += NGW) {
    const int row0 = pr * 2, s = row0 >> 11;
    f32x4 v[2][4];
#pragma unroll
    for (int u = 0; u < 2; ++u)
#pragma unroll
      for (int j = 0; j < 4; ++j) v[u][j] = ld4bf(XMID + (size_t)(row0 + u) * 1024 + lane * 4 + 256 * j);
    f32x4 a[2][4]; moe_combine2(SLOT + (size_t)row0 * 16, YY, lane, a);
    const float* g2 = MOD + ((size_t)(DEPTH - 1) * 9 + s) * 6144 + 5120;
#pragma unroll
    for (int j = 0; j < 4; ++j) { const f32x4 g = *(const f32x4*)(g2 + lane * 4 + 256 * j);
      *(f32x4*)(p.out + (size_t)row0 * 1024 + lane * 4 + 256 * j) = v[0][j] + g * a[0][j];
      *(f32x4*)(p.out + (size_t)(row0 + 1) * 1024 + lane * 4 + 256 * j) = v[1][j] + g * a[1][j]; }
  }
}

__device__ __forceinline__ void unpack8(const u32x4 w, float (&f)[8]) {
  f[0] = __uint_as_float(w.x << 16); f[1] = __uint_as_float(w.x & 0xffff0000u); f[2] = __uint_as_float(w.y << 16); f[3] = __uint_as_float(w.y & 0xffff0000u);
  f[4] = __uint_as_float(w.z << 16); f[5] = __uint_as_float(w.z & 0xffff0000u); f[6] = __uint_as_float(w.w << 16); f[7] = __uint_as_float(w.w & 0xffff0000u);
}
__device__ __forceinline__ u32x4 pack8(const float (&f)[8]) { u32x4 o; o.x = cvt_pk_bf16(f[0], f[1]); o.y = cvt_pk_bf16(f[2], f[3]); o.z = cvt_pk_bf16(f[4], f[5]); o.w = cvt_pk_bf16(f[6], f[7]); return o; }
__device__ __forceinline__ u32x4 head_norm_rope(const u32x4 w, const float (&g)[8], const bool rope, const f32x4 c0, const f32x4 c1, const f32x4 s0, const f32x4 s1, const float sgn) {
  float f[8]; unpack8(w, f);
  float ss = 0.f;
#pragma unroll
  for (int k = 0; k < 8; ++k) ss += f[k] * f[k];
  ss += __shfl_xor(ss, 1); ss += __shfl_xor(ss, 2); ss += __shfl_xor(ss, 4); ss += __shfl_xor(ss, 8);
  const float r = rsqrtf(ss * (1.f / 128.f) + EPS);
#pragma unroll
  for (int k = 0; k < 8; ++k) f[k] *= r * g[k];
  if (rope) { float o[8];
#pragma unroll
    for (int k = 0; k < 8; ++k) { const float pk = __shfl_xor(f[k], 4); const float cs = k < 4 ? c0[k & 3] : c1[k & 3], sn = k < 4 ? s0[k & 3] : s1[k & 3]; o[k] = f[k] * cs + sgn * pk * sn; }
    return pack8(o); }
  return pack8(f);
}
__device__ __forceinline__ void ph_post(int l, LAS unsigned char* lds) {
  CParams& p = *kargs();
  unsigned char* ws = p.ws;
  const int tid = opaque_tid(), lane = tid & 63, wave = tid >> 6;
  const int gw = blockIdx.x * NWAVE + wave, NGW = gridDim.x * NWAVE;
  const bf16_t* PX = (const bf16_t*)(ws + WS_PX);
  bf16_t* QR = (bf16_t*)(ws + WS_QR); bf16_t* KR = (bf16_t*)(ws + WS_KR); bf16_t* VR = (bf16_t*)(ws + WS_VR); bf16_t* CAT = (bf16_t*)(ws + WS_CAT);
  const float* RC = (const float*)(ws + WS_ROPE); const float* RS = RC + 2048;
  float qg[8], kg[8];
  { const f32x4 a = *(const f32x4*)(p.in[I_QG] + l * 128 + (lane & 15) * 8), b = *(const f32x4*)(p.in[I_QG] + l * 128 + (lane & 15) * 8 + 4);
    const f32x4 c = *(const f32x4*)(p.in[I_KG] + l * 128 + (lane & 15) * 8), d = *(const f32x4*)(p.in[I_KG] + l * 128 + (lane & 15) * 8 + 4);
#pragma unroll
    for (int k = 0; k < 4; ++k) { qg[k] = a[k]; qg[4 + k] = b[k]; kg[k] = c[k]; kg[4 + k] = d[k]; } }
  const float sgn = (lane & 4) ? 1.f : -1.f;
  const int half = lane >> 5, l32 = lane & 31, gi = l32 >> 3, w2 = 1 << gi;
  { const bf16_t* YT = (const bf16_t*)(ws + WS_YT); const bf16_t* YTC = (const bf16_t*)(ws + WS_YTC); bf16_t* YF = (bf16_t*)(ws + WS_YF); bf16_t* YFC = (bf16_t*)(ws + WS_YFC);
    const int gt = blockIdx.x * NTHR + tid, ngt = gridDim.x * NTHR;
    {
      LAS bf16_t* rowbuf = (LAS bf16_t*)lds;
      LAS float* ctab = (LAS float*)(lds + 16384);
      for (int i = tid; i < 2048; i += NTHR) { const int m = i < 1024 ? i : i - 2048; ctab[i] = __cosf((float)m * (6.283185307179586f / 2048.f)); }
      constexpr float C8[8] = {1.f, 0.70710678118654752f, 0.f, -0.70710678118654752f, -1.f, -0.70710678118654752f, 0.f, 0.70710678118654752f};
      for (int rp = blockIdx.x; rp < 1024; rp += gridDim.x) {
        __syncthreads();
#pragma unroll
        for (int hh = 0; hh < 2; ++hh) { const int rr = rp * 2 + hh, bb = rr >> 8, lo = rr & 63, lc = lo <= 32 ? lo : 64 - lo, part = tid >> 8;
          const int srow = bb * 256 + ((rr >> 6) & 3) * 64 + (part ? 32 + lc : lc); const bool have = part == 0 || (lc >= 1 && lc <= 31);
          u32x4 w = (u32x4){0u, 0u, 0u, 0u}; if (have) w = *(const u32x4*)(YT + (size_t)srow * 2048 + (tid & 255) * 8);
          *(LAS u32x4*)(rowbuf + hh * 4096 + tid * 8) = w; }
        __syncthreads();
        const int h = tid >> 8, t2 = tid & 255, r = rp * 2 + h, b = r >> 8, hl = r & 255;
        const LAS bf16_t* src = rowbuf + h * 4096;
        const float sgn = (r & 63) > 32 ? -1.f : 1.f;
        float a[8], sv[8];
#pragma unroll
        for (int t1 = 0; t1 < 8; ++t1) { a[t1] = bf2f(src[256 * t1 + t2]); sv[t1] = sgn * bf2f(src[2048 + 256 * t1 + t2]); }
#pragma unroll
        for (int k1 = 0; k1 < 8; ++k1) { float xr = 0.f, xi = 0.f;
#pragma unroll
          for (int t1 = 0; t1 < 8; ++t1) { const float c = C8[(t1 * k1) & 7], sn = C8[((t1 * k1) + 6) & 7]; xr += a[t1] * c - sv[t1] * sn; xi -= a[t1] * sn + sv[t1] * c; }
          const int idx = (t2 * k1) & 2047; const float ct = ctab[idx], st = ctab[(idx + 1536) & 2047];
          bf16_t* dst = YF + (((size_t)(b * 8 + k1) * 256 + hl) * 512) + t2;
          dst[0] = f2bf(xr * ct + xi * st); dst[256] = f2bf(xi * ct - xr * st); }
      }
      __syncthreads(); }
    if (l != DEPTH - 1)
    for (int idx = gt; idx < 8 * 256 * 256; idx += ngt) { const int u = idx & 255, r = idx >> 8, lo = r & 63, lc = lo <= 32 ? lo : 64 - lo; float v;
      const bf16_t* C = YTC + (size_t)((r >> 8) * 256 + ((r >> 6) & 3) * 64 + lc) * 256; const bf16_t* S = C + 32 * 256;
      if (u <= 128) { v = bf2f(C[u]); if (u != 0 && u != 128) v += bf2f(C[256 - u]); }
      else { const int t = u - 128; v = (lc >= 1 && lc <= 31) ? (lo > 32 ? -1.f : 1.f) * (bf2f(S[t]) - bf2f(S[256 - t])) : 0.f; }
      YFC[idx] = f2bf(v); }
  }
  for (int pr = gw; pr < NTOK / 2; pr += NGW) {
    const int row0 = pr * 2;
    const bool lat = row0 < NLAT;
    const int b = lat ? row0 >> 11 : (row0 - NLAT) >> 8, t0 = lat ? row0 & 2047 : (row0 - NLAT) & 255, n = lat ? 2048 : 256;
    u32x4 kv[2];
#pragma unroll
    for (int u = 0; u < 2; ++u) { const bf16_t* px = PX + (size_t)(row0 + u) * 1280; kv[u] = *(const u32x4*)(px + 768 + lane * 8); }
    f32x4 c0[2], c1[2], s0[2], s1[2];
#pragma unroll
    for (int u = 0; u < 2; ++u) { const int t = t0 + u; const int pos = ((lane >> 3) & 1) ? (t & 63) : (t >> 6); const int o = pos * 32 + (lane & 3) * 8;
      c0[u] = *(const f32x4*)(RC + o); c1[u] = *(const f32x4*)(RC + o + 4); s0[u] = *(const f32x4*)(RS + o); s1[u] = *(const f32x4*)(RS + o + 4); }
    { const int t = t0 + half; const int lo = max(t - w2, 0), hi = min(t + w2, n);
      const bf16_t* base = PX + (size_t)(row0 - t0) * 1280 + l32 * 8;
      float acc[8], ctr[8];
#pragma unroll
      for (int k = 0; k < 8; ++k) acc[k] = 0.f;
      u32x4 wv[16];
#pragma unroll
      for (int r = 0; r < 16; ++r) { const int tr = t - 8 + r; const bool ok = tr >= lo && tr < hi; const int trc = ok ? tr : t;
        wv[r] = *(const u32x4*)(base + (size_t)trc * 1280); }
#pragma unroll
      for (int r = 0; r < 16; ++r) { const int tr = t - 8 + r; const bool ok = tr >= lo && tr < hi; float f[8]; unpack8(wv[r], f);
        if (r == 8) {
#pragma unroll
          for (int k = 0; k < 8; ++k) ctr[k] = f[k]; }
#pragma unroll
        for (int k = 0; k < 8; ++k) acc[k] += ok ? f[k] : 0.f; }
      const float ic = 1.f / (float)(hi - lo); float d[8];
#pragma unroll
      for (int k = 0; k < 8; ++k) d[k] = acc[k] * ic - ctr[k];
      *(u32x4*)(CAT + (size_t)(row0 + half) * 1024 + 256 + l32 * 8) = pack8(d); }
#pragma unroll
    for (int u = 0; u < 2; ++u) { const int row = row0 + u, t = t0 + u;
      const u32x4 kk = head_norm_rope(kv[u], kg, lat, c0[u], c1[u], s0[u], s1[u], sgn);
      const size_t kvrow = (size_t)b * KVLEN + (lat ? t : SEQ + t);
      if (lane < 32) *(u32x4*)(KR + kvrow * 256 + lane * 8) = kk; else *(u32x4*)(VR + kvrow * 256 + (lane - 32) * 8) = kv[u]; }
  }
}

__device__ __forceinline__ void ph_mod2(int l, LAS unsigned char* lds) {
  const int nrows = (l == DEPTH - 1) ? NLAT : NTOK;
  CParams& p = *kargs();
  unsigned char* ws = p.ws;
  const int tid = opaque_tid(), lane = tid & 63, wave = tid >> 6;
  const int gw = blockIdx.x * NWAVE + wave, NGW = gridDim.x * NWAVE;
  LAS float* wrt = (LAS float*)lds;
  const float* wr_g = p.in[I_WROUTER] + (size_t)l * 1024 * 16;
  for (int i = tid; i < 1024 * 16 / 4; i += NTHR) { const f32x4 w = *(const f32x4*)(wr_g + i * 4); const int c = i >> 2, e4 = (i & 3) * 4;
    wrt[(e4 + 0) * 1024 + c] = w[0]; wrt[(e4 + 1) * 1024 + c] = w[1]; wrt[(e4 + 2) * 1024 + c] = w[2]; wrt[(e4 + 3) * 1024 + c] = w[3]; }
  __syncthreads();
  const float* MOD = (const float*)(ws + WS_MOD); const bf16_t* XMID = (const bf16_t*)(ws + WS_XMID); bf16_t* HX = (bf16_t*)(ws + WS_HX);
  float* AFF = (float*)(ws + WS_AFF);
  const float* ng = p.in[I_N2G] + l * 1024;
  for (int pr = gw; pr < nrows / 2; pr += NGW) {
    const int row0 = pr * 2;
    const bool lat = row0 < NLAT; const int s = lat ? row0 >> 11 : 8;
    f32x4 y[2][4]; float ss[2];
#pragma unroll
    for (int u = 0; u < 2; ++u) { ss[u] = 0.f;
#pragma unroll
      for (int j = 0; j < 4; ++j) { y[u][j] = ld4bf(XMID + (size_t)(row0 + u) * 1024 + lane * 4 + 256 * j); ss[u] += y[u][j][0] * y[u][j][0] + y[u][j][1] * y[u][j][1] + y[u][j][2] * y[u][j][2] + y[u][j][3] * y[u][j][3]; } }
    const float r0 = rsqrtf(wave_sum(ss[0]) * (1.f / 1024.f) + EPS), r1 = rsqrtf(wave_sum(ss[1]) * (1.f / 1024.f) + EPS);
    const float* ml = MOD + ((size_t)l * 9 + s) * 6144;
    float lg[2][16];
#pragma unroll
    for (int e = 0; e < 16; ++e) { lg[0][e] = 0.f; lg[1][e] = 0.f; }
#pragma unroll 1
    for (int j = 0; j < 4; ++j) { const int c = lane * 4 + 256 * j;
      const f32x4 g = *(const f32x4*)(ng + c), sh = *(const f32x4*)(ml + 3072 + c), scl = *(const f32x4*)(ml + 4096 + c);
      y[0][j] = y[0][j] * r0 * g * (scl + 1.f) + sh; y[1][j] = y[1][j] * r1 * g * (scl + 1.f) + sh;
      st4bf(HX + (size_t)row0 * 1024 + c, y[0][j]); st4bf(HX + (size_t)(row0 + 1) * 1024 + c, y[1][j]);
#pragma unroll
      for (int e = 0; e < 16; ++e) { const f32x4 wv = *(const LAS f32x4*)(wrt + e * 1024 + c);
        lg[0][e] += y[0][j][0] * wv[0] + y[0][j][1] * wv[1] + y[0][j][2] * wv[2] + y[0][j][3] * wv[3];
        lg[1][e] += y[1][j][0] * wv[0] + y[1][j][1] * wv[1] + y[1][j][2] * wv[2] + y[1][j][3] * wv[3];
        if ((e & 7) == 7) asm volatile("" ::: "memory"); } }
#pragma unroll
    for (int u = 0; u < 2; ++u) {
      float a8[8], a4[4], a2[2];
#pragma unroll
      for (int i = 0; i < 8; ++i) { const bool hb = (lane & 32) != 0; const float snd = hb ? lg[u][i] : lg[u][8 + i], kp = hb ? lg[u][8 + i] : lg[u][i]; a8[i] = kp + __shfl_xor(snd, 32); }
#pragma unroll
      for (int i = 0; i < 4; ++i) { const bool hb = (lane & 16) != 0; const float snd = hb ? a8[i] : a8[4 + i], kp = hb ? a8[4 + i] : a8[i]; a4[i] = kp + __shfl_xor(snd, 16); }
#pragma unroll
      for (int i = 0; i < 2; ++i) { const bool hb = (lane & 8) != 0; const float snd = hb ? a4[i] : a4[2 + i], kp = hb ? a4[2 + i] : a4[i]; a2[i] = kp + __shfl_xor(snd, 8); }
      float mine; { const bool hb = (lane & 4) != 0; const float snd = hb ? a2[0] : a2[1], kp = hb ? a2[1] : a2[0]; mine = kp + __shfl_xor(snd, 4); }
      mine += __shfl_xor(mine, 1); mine += __shfl_xor(mine, 2);
      float mx = mine;
#pragma unroll
      for (int o = 4; o < 64; o <<= 1) mx = fmaxf(mx, __shfl_xor(mx, o));
      const float ex = __expf(mine - mx); float sm = ex;
#pragma unroll
      for (int o = 4; o < 64; o <<= 1) sm += __shfl_xor(sm, o);
      const float aff = ex / sm;
      const int e = ((lane >> 5) & 1) * 8 + ((lane >> 4) & 1) * 4 + ((lane >> 3) & 1) * 2 + ((lane >> 2) & 1), row = row0 + u;
      if ((lane & 3) == 0) { if (lat) AFF[((size_t)(row >> 11) * 16 + e) * 2048 + (row & 2047)] = aff;
        else { const int rc = row - NLAT; AFF[(size_t)128 * 2048 + ((size_t)(rc >> 8) * 16 + e) * 256 + (rc & 255)] = aff; } }
    }
  }
  __syncthreads();
}

__device__ __forceinline__ void ph_topk(int l, LAS unsigned char* lds) {
  const int nprob = (l == DEPTH - 1) ? 128 : 256;
  CParams& p = *kargs();
  unsigned char* ws = p.ws;
  const int tid = opaque_tid(), lane = tid & 63, wave = tid >> 6;
  LAS unsigned* hist = (LAS unsigned*)lds;
  LAS unsigned* wtot = hist + 256;
  LAS unsigned* res = hist + 272;
  const float* AFF = (const float*)(ws + WS_AFF); float* GATE = (float*)(ws + WS_GATE); int* SLOT = (int*)(ws + WS_SLOT);
  int* IDX = (int*)(ws + WS_IDX);
  for (int q = blockIdx.x; q < nprob; q += gridDim.x) {
    const bool lat = q < 128; const int qq = lat ? q : q - 128; const int b = qq >> 4, e = qq & 15;
    const int n = lat ? 2048 : 256, cap = lat ? CAPL : CAPC;
    const float* aff = AFF + (lat ? (size_t)qq * 2048 : (size_t)128 * 2048 + (size_t)qq * 256);
    const int i0 = tid * 4; const bool valid = i0 < n;
    unsigned k[4];
    { f32x4 a4 = (f32x4){0.f, 0.f, 0.f, 0.f}; if (valid) a4 = *(const f32x4*)(aff + i0);
#pragma unroll
      for (int r = 0; r < 4; ++r) k[r] = __float_as_uint(a4[r]); }
    unsigned prefix = 0u, mask = 0u, remaining = (unsigned)cap;
    for (int shift = 24; shift >= 0; shift -= 8) {
      __syncthreads();
      if (tid < 256) hist[tid] = 0u;
      __syncthreads();
      if (valid) {
#pragma unroll
        for (int r = 0; r < 4; ++r) if ((k[r] & mask) == prefix) atomicAdd((unsigned*)&hist[(k[r] >> shift) & 255u], 1u); }
      __syncthreads();
      unsigned hv = 0u, sfx = 0u;
      if (tid < 256) { hv = hist[tid]; sfx = hv;
#pragma unroll
        for (int o = 1; o < 64; o <<= 1) { const unsigned t = __shfl_down(sfx, o); if (lane + o < 64) sfx += t; }
        if (lane == 0) wtot[wave] = sfx; }
      __syncthreads();
      if (tid < 256) { unsigned above = 0u;
#pragma unroll
        for (int w = 1; w < 4; ++w) if (w > wave) above += wtot[w];
        const unsigned incl = sfx + above, excl = incl - hv;
        if (excl < remaining && remaining <= incl) { res[0] = (unsigned)tid; res[1] = remaining - excl; res[2] = hv; } }
      __syncthreads();
      prefix |= res[0] << shift; mask |= 255u << shift; remaining = res[1];
    }
    const unsigned T = prefix, need_eq = remaining, tot_eq = res[2];
    bool sel[4]; int cnt = 0;
#pragma unroll
    for (int r = 0; r < 4; ++r) { bool sl = valid && (k[r] > T || (k[r] == T && tot_eq == need_eq));
      if (valid && k[r] == T && tot_eq != need_eq) { unsigned rk = 0u; for (int j = 0; j < i0 + r; ++j) rk += (__float_as_uint(aff[j]) == T) ? 1u : 0u; sl = rk < need_eq; }
      sel[r] = sl; cnt += sl ? 1 : 0; }
    int incl = cnt;
#pragma unroll
    for (int o = 1; o < 64; o <<= 1) { const int t = __shfl_up(incl, o); if (lane >= o) incl += t; }
    __syncthreads();
    if (lane == 63) wtot[wave] = (unsigned)incl;
    __syncthreads();
    int base = incl - cnt;
#pragma unroll
    for (int w = 0; w < 8; ++w) if (w < wave) base += (int)wtot[w];
    const int tokbase = lat ? b * SEQ : NLAT + b * CTXL;
    const int yrow0 = e * EROWS + (lat ? b * CAPL : NB * CAPL + b * CAPC);
    if (valid) {
#pragma unroll
      for (int r = 0; r < 4; ++r) { const int tok = tokbase + i0 + r;
        if (sel[r]) { SLOT[(size_t)tok * 16 + e] = yrow0 + base; GATE[yrow0 + base] = __uint_as_float(k[r]); IDX[yrow0 + base] = tok; ++base; }
        else SLOT[(size_t)tok * 16 + e] = -1; } }
    __syncthreads();
  }
}

#ifndef PH_MASK
#define PH_MASK 0xFFFF
#endif
#ifndef DUP_MASK
#define DUP_MASK 0
#endif
#define REPS(bit) for (int rep_ = 0; rep_ < 1 + ((DUP_MASK & (bit)) ? 1 : 0); ++rep_)
#define GSYNC() do { xcd_barrier(xst); if (DUP_MASK & 4096) xcd_barrier(xst); } while (0)
__global__ void __launch_bounds__(NTHR, 2) fwd_mega(Params p) {
  extern __shared__ __attribute__((aligned(16))) unsigned char lds_raw[];
  LAS unsigned char* lds = (LAS unsigned char*)lds_raw;
  cg::grid_group grid = cg::this_grid();
  const int G = gridDim.x;
  const int bx = (G % 8 == 0) ? ((int)blockIdx.x % 8) * (G / 8) + (int)blockIdx.x / 8 : (int)blockIdx.x;

  volatile LAS unsigned* xst = (volatile LAS unsigned*)(lds + 131072);
  if (threadIdx.x == 0) { xst[0] = 0u; xst[1] = 0u; }
  __syncthreads();
  xcd_barrier_post((unsigned*)(kargs()->ws + WS_BAR));
  REPS(1) if (PH_MASK & 1) ph_prep(lds);
  GSYNC();
  if (gridDim.x == 0x7fffffffu) grid.sync();

  for (int l = 0; l < DEPTH; ++l) {
    const bool last = (l == DEPTH - 1);
    REPS(2) if (PH_MASK & 2) ph_mod1(l);
    GSYNC();
    REPS(4) if (PH_MASK & 4) {
      unsigned char* ws = kargs()->ws;
      pg8::Gemm g{(const bf16_t*)(ws + WS_HX), (const bf16_t*)(ws + WS_WP) + (size_t)l * 1280 * 1024, 1024, 1024, 1024};
      pg8::Sched S{72, 5, 360, G, bx, 72};
      pg8::EpiBf16 E{(bf16_t*)(ws + WS_PX), 1280};
      pg8::gemm_phase<pg8::EpiBf16>(lds, g, S, E);
    }
    REPS(4) if (PH_MASK & 8) {
      unsigned char* ws = kargs()->ws;
      pg8::Gemm g{(const bf16_t*)(ws + WS_WF) + (size_t)l * 256 * 1024, (const bf16_t*)(ws + WS_HX), 1024, 1024, 1024};
      pg8::Sched S{1, 72, 72, G, (bx + G - (360 % G)) % G, 1};
      pg8::EpiYT E{(bf16_t*)(ws + WS_YT), (bf16_t*)(ws + WS_YTC)};
      pg8::gemm_phase<pg8::EpiYT>(lds, g, S, E);
    }
    GSYNC();
    REPS(16) if (PH_MASK & 16) ph_post(l, lds);
    GSYNC();
    REPS(32) if (PH_MASK & 32) {
      unsigned char* ws = kargs()->ws;
      const bf16_t* QR = (const bf16_t*)(ws + WS_QR); const bf16_t* KR = (const bf16_t*)(ws + WS_KR); const bf16_t* VR = (const bf16_t*)(ws + WS_VR); bf16_t* CAT = (bf16_t*)(ws + WS_CAT);
      REPS(16384) for (int u = bx; u < (last ? 256 : 288); u += G) {
        const bool lat = u < 256; const int uu = lat ? u : u - 256;
        const int b = lat ? uu >> 5 : uu >> 2, h = lat ? (uu >> 3) & 3 : uu & 3, qb = lat ? uu & 7 : 0;
        const size_t tok = lat ? (size_t)b * SEQ + qb * 256 : (size_t)NLAT + b * CTXL;
        const size_t kv = ((size_t)b * KVLEN + (lat ? 0 : SEQ)) * 256 + (h >> 1) * 128;
        att::attn_dense_body((const bf16_t*)(ws + WS_PX) + tok * 1280 + 256 + h * 128, KR + kv, VR + kv, CAT + tok * 1024 + 512 + h * 128, lat ? KVLEN : CTXL, (char*)lds_raw,
                             kargs()->in[I_QG] + l * 128, (const float*)(ws + WS_ROPE), (const float*)(ws + WS_ROPE) + 2048, lat, qb * 256);
      }
      { pg8::Gemm g{(const bf16_t*)(ws + WS_DFTM), (const bf16_t*)(ws + WS_YF), 512, 512, 512};
        pg8::Sched S{1, 64, 64, G, (bx + G - (32 % G)) % G, 1};
        pg8::EpiDft2 E{CAT, 0.0027621358640099515f};
        pg8::gemm_phase<pg8::EpiDft2>(lds, g, S, E); }
      { pg8::Gemm g{(const bf16_t*)(ws + WS_DFTC), (const bf16_t*)(ws + WS_YFC), 256, 256, 256};
        pg8::Sched S{1, 8, last ? 0 : 8, G, (bx + G - (96 % G)) % G, 1};
        pg8::EpiDft E{CAT, NLAT, CTXL, 0.0078125f};
        pg8::gemm_phase<pg8::EpiDft>(lds, g, S, E); }
      { const int cq = (bx + G - (32 % G)) % G;
        const int clo = (G == 256) ? (l == 0 ? CONV_P : (last ? CONV_C : CONV_B)) : 0;
        const int chi = (last || G != 256) ? 16 * 1536 : (l == 0 ? CONV_SPLIT : CONV_B);
        const int s1 = (G <= 72) ? chi : clo + ((chi - clo) / 4) * 3;
        if (chi > clo) { convert_moe_weights(l, bx, G, clo, s1, lds);
          if (G > 72 && cq >= 72) convert_moe_weights(l, cq - 72, G - 72, s1, chi, lds); } }
    }
    GSYNC();
    REPS(64) if (PH_MASK & 64) {
      unsigned char* ws = kargs()->ws;
      pg8::Gemm g{(const bf16_t*)(ws + WS_CAT), (const bf16_t*)(ws + WS_WO) + (size_t)l * 1024 * 1024, 1024, 1024, 1024};
      pg8::Sched S{last ? 64 : 72, 4, last ? 256 : 288, G, bx, 72};
      pg8::EpiOut E{(const bf16_t*)(ws + WS_X), (bf16_t*)(ws + WS_XMID), (const float*)(ws + WS_MOD) + (size_t)l * 9 * 6144};
      pg8::gemm_phase<pg8::EpiOut>(lds, g, S, E);
      if (!last && G == 256 && bx >= 32) { convert_moe_weights(l, bx - 32, G - 32, l == 0 ? CONV_SPLIT : CONV_B, 16 * 1536, lds);
        if (l == DEPTH - 2) convert_moe_weights(l + 1, bx - 32, G - 32, CONV_B, CONV_C, lds); }
    }
    GSYNC();
    REPS(128) if (PH_MASK & 128) ph_mod2(l, lds);
    GSYNC();
    REPS(256) if (PH_MASK & 256) ph_topk(l, lds);
    GSYNC();
    REPS(512) if (PH_MASK & 512) {
      unsigned char* ws = kargs()->ws;
      pg8::Gemm g{(const bf16_t*)(ws + WS_HX), (const bf16_t*)(ws + ((l & 1) ? WS_WGU2 : WS_WGU)), 1024, 1024, 1024};
      pg8::Sched S{last ? 8 : 9, 8, last ? 16 * 64 : 16 * 72, G, bx, 9};
      pg8::EpiMoe1 E{(bf16_t*)(ws + WS_HH)};
      pg8::gemm_phase_gather<pg8::EpiMoe1>(lds, g, (const int*)(ws + WS_IDX), S, E);
      if (!last && G == 256 && bx >= 128) convert_moe_weights(l + 1, bx - 128, 128, 0, CONV_A, lds);
    }
    GSYNC();
    REPS(1024) if (PH_MASK & 1024) {
      unsigned char* ws = kargs()->ws;
      pg8::Gemm g{(const bf16_t*)(ws + WS_HH), (const bf16_t*)(ws + ((l & 1) ? WS_WD2 : WS_WD)), 1024, 1024, 1024};
      pg8::Sched S{last ? 8 : 9, 4, last ? 16 * 32 : 16 * 36, G, bx, 9};
      pg8::EpiMoe2 E{(bf16_t*)(ws + WS_XS), (const float*)(ws + WS_GATE)};
      pg8::gemm_phase<pg8::EpiMoe2>(lds, g, S, E);
      if (!last && G == 256 && bx >= 64) convert_moe_weights(l + 1, bx - 64, 192, CONV_A, CONV_B, lds);
    }
    GSYNC();
  }
  if (PH_MASK & 2048) ph_final();
}

extern "C" void kernel_launch(void* const* d_in, const int* in_sizes, int n_in, void* d_out, int out_size,
                              void* d_ws, size_t ws_size, hipStream_t stream) {
  static int grid_blocks = 0;
  if (grid_blocks == 0) {
    if (n_in != N_IN || out_size != NLAT * DM || ws_size < WS_END) {
      fprintf(stderr, "kernel_launch: unexpected shapes: n_in %d out %d ws %zu (need %zu)\n", n_in, out_size, ws_size, (size_t)WS_END); grid_blocks = -1; return; }
    int dev = 0, cus = 0, per_cu = 0;
    if (hipGetDevice(&dev) != hipSuccess || hipDeviceGetAttribute(&cus, hipDeviceAttributeMultiprocessorCount, dev) != hipSuccess) { grid_blocks = -1; return; }
    if (hipFuncSetAttribute((const void*)fwd_mega, hipFuncAttributeMaxDynamicSharedMemorySize, LDS_BYTES) != hipSuccess) { fprintf(stderr, "kernel_launch: hipFuncSetAttribute failed\n"); grid_blocks = -1; return; }
    if (hipOccupancyMaxActiveBlocksPerMultiprocessor(&per_cu, (const void*)fwd_mega, NTHR, LDS_BYTES) != hipSuccess || per_cu < 1) { fprintf(stderr, "kernel_launch: occupancy query says %d\n", per_cu); per_cu = 1; }
    (void)hipGetLastError();
    grid_blocks = cus;
  }
  if (grid_blocks < 0) return;
  Params p{};
  for (int i = 0; i < N_IN; ++i) p.in[i] = (const float*)d_in[i];
  p.out = (float*)d_out; p.ws = (unsigned char*)d_ws;
  if (hipMemsetAsync((char*)d_ws + WS_BAR, 0, 16384, stream) != hipSuccess) { fprintf(stderr, "kernel_launch: memset failed\n"); return; }
  void* args[] = {&p};
  hipError_t e = hipLaunchCooperativeKernel((void*)fwd_mega, dim3(grid_blocks), dim3(NTHR), args, LDS_BYTES, stream);
  if (e != hipSuccess) fprintf(stderr, "cooperative launch failed: %s (grid %d)\n", hipGetErrorString(e), grid_blocks);
}
```

```cpp
#include <hip/hip_runtime.h>
#include <hip/hip_cooperative_groups.h>
#include <cstdio>
#include <cstdint>
namespace cg = cooperative_groups;

typedef unsigned short bf16_t;
typedef short bf16x8 __attribute__((ext_vector_type(8)));
typedef short s16x4 __attribute__((ext_vector_type(4)));
typedef float f32x4 __attribute__((ext_vector_type(4)));
typedef float f32x16 __attribute__((ext_vector_type(16)));
typedef unsigned u32x4 __attribute__((ext_vector_type(4)));
typedef unsigned u32x2 __attribute__((ext_vector_type(2)));
#define LAS __attribute__((address_space(3)))

constexpr int DM = 1024, NB = 8, SEQ = 2048, CTXL = 256, NLAT = NB * SEQ, NCTX = NB * CTXL, NTOK = NLAT + NCTX, DEPTH = 4;
constexpr int NE = 16, CAPL = 256, CAPC = 32, EROWS = NB * CAPL + NB * CAPC;
constexpr int KVLEN = SEQ + CTXL;
constexpr float EPS = 1e-6f;
constexpr int NTHR = 512, NWAVE = 8;
constexpr int LDS_BYTES = 132 * 1024;
constexpr int CONV_SPLIT = 11264;

enum { I_X = 0, I_C, I_CTX, I_CCTX, I_ADAW, I_ADAB, I_N1G, I_N2G, I_WIN, I_WFOU, I_WPOOL, I_PSCALE, I_QG, I_KG, I_WOUT, I_WROUTER, I_WGATE, I_WUP, I_WDOWN, N_IN };
struct Params { const float* in[N_IN]; float* out; unsigned char* ws; };
typedef const __attribute__((address_space(4))) Params CParams;
__device__ __forceinline__ CParams* kargs() { CParams* q = (CParams*)__builtin_amdgcn_kernarg_segment_ptr(); asm volatile("" : "+s"(q)); return q; }

constexpr size_t al256(size_t x) { return (x + 255) & ~(size_t)255; }
constexpr size_t WS_BAR  = 0;
constexpr size_t WS_MOD  = 16384;
constexpr size_t WS_ROPE = WS_MOD + al256((size_t)4 * 9 * 6144 * 4);
constexpr size_t WS_DFTM = WS_ROPE + al256((size_t)2 * 2048 * 4);
constexpr size_t WS_DFTC = WS_DFTM + (size_t)2048 * 4096 * 2;
constexpr size_t WS_WF   = WS_DFTC + (size_t)256 * 512 * 2;
constexpr size_t WS_WP   = WS_WF + (size_t)4 * 512 * 1024 * 2;
constexpr size_t WS_WO   = WS_WP + (size_t)4 * 1280 * 1024 * 2;
constexpr size_t WS_WGU  = WS_WO + (size_t)4 * 1024 * 1024 * 2;
constexpr size_t WS_WD   = WS_WGU + (size_t)16 * 2048 * 1024 * 2;
constexpr size_t WS_X    = WS_WD + (size_t)16 * 1024 * 1024 * 2;
constexpr size_t WS_XMID = WS_X + (size_t)NTOK * 1024 * 4;
constexpr size_t WS_HX   = WS_XMID + (size_t)NTOK * 1024 * 4;
constexpr size_t WS_AFF  = WS_HX + (size_t)NTOK * 1024 * 2;
constexpr size_t WS_GATE = WS_AFF + (size_t)(8 * 16 * 2048 + 8 * 16 * 256) * 4;
constexpr size_t WS_IDX  = WS_GATE + al256((size_t)16 * 2304 * 4);
constexpr size_t WS_SLOT = WS_IDX + al256((size_t)16 * 2304 * 4);
constexpr size_t WS_R1   = WS_SLOT + (size_t)NTOK * 16 * 4;
constexpr size_t WS_PX   = WS_R1;
constexpr size_t WS_YT   = WS_PX + (size_t)NTOK * 1280 * 2;
constexpr size_t WS_YTC  = WS_YT + (size_t)8 * 256 * 4096 * 2;
constexpr size_t WS_QR   = WS_YTC + (size_t)8 * 256 * 512 * 2;
constexpr size_t WS_KR   = WS_QR + (size_t)NTOK * 512 * 2;
constexpr size_t WS_VR   = WS_KR + (size_t)8 * 2304 * 256 * 2;
constexpr size_t WS_CAT  = WS_VR + (size_t)8 * 2304 * 256 * 2;
constexpr size_t WS_YF   = WS_CAT + (size_t)NTOK * 1024 * 2;
constexpr size_t WS_YFC  = WS_YF + (size_t)8 * 8 * 256 * 512 * 2;
constexpr size_t WS_R1A_END = WS_YFC + (size_t)8 * 256 * 256 * 2;
constexpr size_t WS_XS   = WS_R1;
constexpr size_t WS_HH   = WS_XS + (size_t)16 * 2304 * 1024 * 2;
constexpr size_t WS_R1B_END = WS_HH + (size_t)16 * 2304 * 1024 * 2;
constexpr size_t WS_END0 = WS_R1A_END > WS_R1B_END ? WS_R1A_END : WS_R1B_END;

constexpr size_t WS_WGU2 = WS_END0;
constexpr size_t WS_WD2  = WS_WGU2 + (size_t)16 * 2048 * 1024 * 2;
constexpr size_t WS_END  = WS_WD2 + (size_t)16 * 1024 * 1024 * 2;
constexpr int CONV_Q = 8704;
constexpr int CONV_P = 4608;
constexpr int CONV_A = 6144, CONV_B = 15360, CONV_C = 21504;
constexpr int CONV_UNUSED_ = 0;

__device__ __forceinline__ int opaque_tid() { int t = threadIdx.x; asm volatile("" : "+v"(t)); return t; }
__device__ __forceinline__ unsigned cvt_pk_bf16(float lo, float hi) { unsigned r; asm volatile("v_cvt_pk_bf16_f32 %0, %1, %2" : "=v"(r) : "v"(lo), "v"(hi)); return r; }
__device__ __forceinline__ float bf2f(bf16_t b) { return __uint_as_float(((unsigned)b) << 16); }
__device__ __forceinline__ bf16_t f2bf(float f) { return (bf16_t)(cvt_pk_bf16(f, 0.f) & 0xffffu); }
__device__ __forceinline__ float wave_sum(float v) {
#pragma unroll
  for (int o = 1; o < 64; o <<= 1) v += __shfl_xor(v, o);
  return v;
}
#define LDS_WAIT() asm volatile("s_waitcnt lgkmcnt(0)" ::: "memory")
__device__ __forceinline__ f32x4 ld4bf(const bf16_t* p) { const u32x2 w = *(const u32x2*)p; return (f32x4){__uint_as_float(w.x << 16), __uint_as_float(w.x & 0xffff0000u), __uint_as_float(w.y << 16), __uint_as_float(w.y & 0xffff0000u)}; }
__device__ __forceinline__ void st4bf(bf16_t* p, const f32x4 v) { u32x2 w; w.x = cvt_pk_bf16(v[0], v[1]); w.y = cvt_pk_bf16(v[2], v[3]); *(u32x2*)p = w; }


#define XB_TMO      128
#define XB_XCNT(j)  (256  + 64 * (j))
#define XB_XSUB(j)  (1280 + 64 * (j))
#define XB_XGEN(j)  (2304 + 64 * (j))
#define XB_TOP      3328
#define XB_TOPGEN   3392
#define XCD_BAR_WORDS 3456
#define XB_SPIN_CAP (1u << 18)
__device__ __forceinline__ unsigned xb_ld(unsigned* p)              { return __hip_atomic_load(p, __ATOMIC_RELAXED, __HIP_MEMORY_SCOPE_AGENT); }
__device__ __forceinline__ unsigned xb_add(unsigned* p, unsigned v) { return __hip_atomic_fetch_add(p, v, __ATOMIC_RELAXED, __HIP_MEMORY_SCOPE_AGENT); }
__device__ __forceinline__ unsigned xb_xcc_id() { return (unsigned)__builtin_amdgcn_s_getreg((3 << 11) | 20) & 0xFu; }
#define XB_SPIN(cond, bar) do { unsigned _sp = 0; while (cond) { __builtin_amdgcn_s_sleep(1); \
    if ((++_sp & 255u) == 0u) { if (xb_ld(&(bar)[XB_TMO])) break; if (_sp > XB_SPIN_CAP) { atomicAdd(&(bar)[XB_TMO], 1u); break; } } } } while (0)
__device__ __forceinline__ void xcd_barrier_post(unsigned* bar) { if (threadIdx.x == 0) (void)xb_add(&bar[XB_XCNT(xb_xcc_id())], 1u); }
__device__ __forceinline__ void xcd_barrier_complete(unsigned* bar, unsigned x, unsigned& nloc, unsigned& nx) {
    const unsigned G = gridDim.x * gridDim.y * gridDim.z;
    unsigned sum, cnt, mine, sp = 0u;
    for (;;) {
        sum = 0u; cnt = 0u; mine = 0u;
#pragma unroll
        for (unsigned j = 0; j < 16; ++j) { const unsigned c = xb_ld(&bar[XB_XCNT(j)]); sum += c; cnt += (c > 0u) ? 1u : 0u; mine = (j == x) ? c : mine; }
        if (sum == G) break;
        __builtin_amdgcn_s_sleep(1);
        if ((++sp & 255u) == 0u) { if (xb_ld(&bar[XB_TMO])) break; if (sp > XB_SPIN_CAP) { atomicAdd(&bar[XB_TMO], 1u); break; } }
    }
    nloc = mine > 0u ? mine : 1u; nx = cnt > 0u ? cnt : 1u;
}
__device__ __forceinline__ void xcd_barrier(volatile LAS unsigned* st) {
    asm volatile("s_waitcnt vmcnt(0)" ::: "memory");
    __syncthreads();
    if (threadIdx.x == 0) {
        unsigned* bar = (unsigned*)(kargs()->ws + WS_BAR); const unsigned x = xb_xcc_id();
        __builtin_amdgcn_s_waitcnt(0);
        unsigned nloc = st[0], nx = st[1];
        if (nloc == 0u) { xcd_barrier_complete(bar, x, nloc, nx); st[0] = nloc; st[1] = nx; }
        const unsigned old = xb_add(&bar[XB_XSUB(x)], 1u);
        const unsigned gen = old / nloc;
        if (old + 1u == (gen + 1u) * nloc) {
            __builtin_amdgcn_fence(__ATOMIC_RELEASE, "agent");
            asm volatile("s_waitcnt vmcnt(0)" ::: "memory");
            const unsigned og = xb_add(&bar[XB_TOP], 1u);
            const unsigned tg = og / nx;
            if (og + 1u == (tg + 1u) * nx) xb_add(&bar[XB_TOPGEN], 1u);
            else XB_SPIN(xb_ld(&bar[XB_TOPGEN]) == tg, bar);
            __builtin_amdgcn_fence(__ATOMIC_ACQUIRE, "agent");
            xb_add(&bar[XB_XGEN(x)], 1u);
            asm volatile("s_waitcnt vmcnt(0)" ::: "memory");
        } else {
            XB_SPIN(xb_ld(&bar[XB_XGEN(x)]) == gen, bar);
            __builtin_amdgcn_fence(__ATOMIC_ACQUIRE, "agent");
            asm volatile("s_waitcnt vmcnt(0)" ::: "memory");
        }
    }
    __syncthreads();
}

namespace pg8 {
constexpr int BM = 256, BK = 64, HALF = 128, HTB = HALF * BK * 2, STAGE_BYTES = 8 * HTB;
__device__ __forceinline__ int lds_byte(int r, int c) { const int st = (r >> 4) * 2 + (c >> 5), rr = r & 15, cc = c & 31, ob = rr * 64 + cc * 2; return st * 1024 + (ob ^ (((ob >> 9) & 1) << 5)); }
__device__ __forceinline__ void stage_rc(int b, int& R, int& C) { const int st = b / 1024, sb = b % 1024, swz = sb ^ (((sb >> 9) & 1) << 5); R = (st >> 1) * 16 + swz / 64; C = (st & 1) * 32 + (swz % 64) / 2; }
__device__ __forceinline__ int perm32(int rho) { const int n = rho >> 4, i = rho & 15; return 8 * (i >> 2) + 4 * n + (i & 3); }

struct Unit { int pm, pn; };
struct Gemm { const bf16_t* A; const bf16_t* Bt; int lda, ldb, K; };

struct Sched {
  int gm, gn, total, G, c, gs;
  __device__ __forceinline__ bool next(int i, Unit& u) const {
    const long L = (long)i * G + c; if (L >= total) return false;
    const int per = gm * gn, g = (int)L / per, r = (int)L % per;
    u.pm = g * gs + r / gn; u.pn = g * gn + r % gn; return true;
  }
};

template <class Epi>
__device__ __forceinline__ void gemm_phase(LAS unsigned char* lds, const Gemm g, const Sched& S, const Epi& E) {
  const int tid = opaque_tid(), wid = __builtin_amdgcn_readfirstlane(tid >> 6), lane = tid & 63, wr = wid >> 2, wc = wid & 3, fr = lane & 15, fq = lane >> 4;
  const int K = g.K, nt = K / BK;
  unsigned voffA[2], voffB[2];
#pragma unroll
  for (int i = 0; i < 2; ++i) { int R, C; stage_rc(tid * 16 + i * 8192, R, C); const int Rb = Epi::PERM ? ((R & ~31) + perm32(R & 31)) : R;
    voffA[i] = (unsigned)(R * g.lda + C) * 2u; voffB[i] = (unsigned)(Rb * g.ldb + C) * 2u; }
  const size_t kstep = (size_t)(BK * 2);
  const size_t hstepA = (size_t)HALF * g.lda * 2, hstepB = (size_t)HALF * g.ldb * 2;
  const size_t tstepA = 2 * hstepA, tstepB = 2 * hstepB;
  const unsigned ldsw = (unsigned)wid * 1024u;
  const int aoff = lds_byte(wr * 64 + fr, fq * 8), boff = lds_byte(wc * 32 + fr, fq * 8);
#define PG8_SA(b, h) (((b) * 2 + (h)) * HTB)
#define PG8_SB(b, h) ((4 + (b) * 2 + (h)) * HTB)
#define PG8_STAGE(bufoff, gbase, voff) do { _Pragma("unroll") for (int _i = 0; _i < 2; ++_i) \
    __builtin_amdgcn_global_load_lds((const unsigned*)((const char*)(gbase) + (voff)[_i]), (LAS unsigned*)(lds + (bufoff) + ldsw + _i * 8192), 16, 0, 0); } while (0)
#define PG8_LDA(dst, b, h) do { _Pragma("unroll") for (int m = 0; m < 4; ++m) _Pragma("unroll") for (int k = 0; k < 2; ++k) dst[m][k] = *(const LAS bf16x8*)(lds + PG8_SA(b, h) + aoff + m * 2048 + k * 1024); } while (0)
#define PG8_LDB(dst, b, h) do { _Pragma("unroll") for (int n = 0; n < 2; ++n) _Pragma("unroll") for (int k = 0; k < 2; ++k) dst[n][k] = *(const LAS bf16x8*)(lds + PG8_SB(b, h) + boff + n * 2048 + k * 1024); } while (0)
#define PG8_MMA(ai, bj, At, Bt) do { __builtin_amdgcn_s_setprio(1); _Pragma("unroll") for (int m = 0; m < 4; ++m) _Pragma("unroll") for (int n = 0; n < 2; ++n) _Pragma("unroll") for (int k = 0; k < 2; ++k) \
    acc[ai][bj][m][n] = __builtin_amdgcn_mfma_f32_16x16x32_bf16(Bt[n][k], At[m][k], acc[ai][bj][m][n], 0, 0, 0); __builtin_amdgcn_s_setprio(0); } while (0)
#define PG8_WAIT_V(n) asm volatile("s_waitcnt vmcnt(" #n ")" ::: "memory")
#define PG8_WAIT_L(n) asm volatile("s_waitcnt lgkmcnt(" #n ")" ::: "memory")
#define PG8_BAR __builtin_amdgcn_s_barrier()
#define PG8_SCHED __builtin_amdgcn_sched_barrier(0)
  Unit cur, nxt; int ui = 0;
  if (!S.next(0, cur)) return;
  f32x4 acc[2][2][4][2];
#pragma unroll
  for (int a = 0; a < 2; ++a)
#pragma unroll
    for (int b = 0; b < 2; ++b)
#pragma unroll
      for (int m = 0; m < 4; ++m)
#pragma unroll
        for (int n = 0; n < 2; ++n) acc[a][b][m][n] = (f32x4){0.f, 0.f, 0.f, 0.f};
  bf16x8 At[4][2], B0[2][2], B1[2][2];
  const char* cA = (const char*)g.A + (size_t)cur.pm * tstepA; const char* cB = (const char*)g.Bt + (size_t)cur.pn * tstepB;
  PG8_STAGE(PG8_SB(0, 0), cB, voffB); PG8_STAGE(PG8_SA(0, 0), cA, voffA); PG8_STAGE(PG8_SB(0, 1), cB + hstepB, voffB); PG8_STAGE(PG8_SA(0, 1), cA + hstepA, voffA);
  if (wr == 1) PG8_BAR;
  PG8_WAIT_V(4); PG8_BAR;
  PG8_STAGE(PG8_SB(1, 0), cB + kstep, voffB); PG8_STAGE(PG8_SA(1, 0), cA + kstep, voffA); PG8_STAGE(PG8_SB(1, 1), cB + hstepB + kstep, voffB);
  PG8_WAIT_V(6); PG8_BAR;
  for (;;) {
    const bool has_next = S.next(ui + 1, nxt);
    const char* nA = has_next ? (const char*)g.A + (size_t)nxt.pm * tstepA : cA; const char* nB = has_next ? (const char*)g.Bt + (size_t)nxt.pn * tstepB : cB;
    for (int t = 0; t < nt; t += 2) {
      const bool last = (t == nt - 2);
      const char* a1 = cA + (size_t)(t + 1) * kstep;
      const char* a2 = last ? nA : cA + (size_t)(t + 2) * kstep; const char* b2 = last ? nB : cB + (size_t)(t + 2) * kstep;
      const char* a3 = a2 + kstep; const char* b3 = b2 + kstep;
      PG8_LDB(B0, 0, 0); PG8_SCHED; PG8_LDA(At, 0, 0); PG8_STAGE(PG8_SA(1, 1), a1 + hstepA, voffA);
      PG8_WAIT_L(8); PG8_BAR; PG8_WAIT_L(0); PG8_MMA(0, 0, At, B0); PG8_BAR; PG8_SCHED;
      PG8_LDB(B1, 0, 1); PG8_STAGE(PG8_SB(0, 0), b2, voffB);
      PG8_BAR; PG8_WAIT_L(0); PG8_MMA(0, 1, At, B1); PG8_BAR;
      PG8_LDA(At, 0, 1); PG8_STAGE(PG8_SA(0, 0), a2, voffA);
      PG8_BAR; PG8_WAIT_L(0); PG8_MMA(1, 0, At, B0); PG8_BAR; PG8_SCHED;
      PG8_STAGE(PG8_SB(0, 1), b2 + hstepB, voffB);
      PG8_WAIT_V(6); PG8_BAR; PG8_MMA(1, 1, At, B1); PG8_BAR;
      PG8_LDB(B0, 1, 0); PG8_SCHED; PG8_LDA(At, 1, 0); PG8_STAGE(PG8_SA(0, 1), a2 + hstepA, voffA);
      PG8_WAIT_L(8); PG8_BAR; PG8_WAIT_L(0); PG8_MMA(0, 0, At, B0); PG8_BAR; PG8_SCHED;
      PG8_LDB(B1, 1, 1); PG8_STAGE(PG8_SB(1, 0), b3, voffB);
      PG8_BAR; PG8_WAIT_L(0); PG8_MMA(0, 1, At, B1); PG8_BAR;
      PG8_LDA(At, 1, 1); PG8_STAGE(PG8_SA(1, 0), a3, voffA);
      PG8_BAR; PG8_WAIT_L(0); PG8_MMA(1, 0, At, B0); PG8_BAR; PG8_SCHED;
      PG8_STAGE(PG8_SB(1, 1), b3 + hstepB, voffB);
      PG8_WAIT_V(6); PG8_BAR; PG8_MMA(1, 1, At, B1); PG8_BAR;
    }
    E(acc, cur, wr, wc, fr, fq);
#if defined(DUP_MASK)
    if (DUP_MASK & 8192) E(acc, cur, wr, wc, fr, fq);
#endif
    if (!has_next) break;
#pragma unroll
    for (int a = 0; a < 2; ++a)
#pragma unroll
      for (int b = 0; b < 2; ++b)
#pragma unroll
        for (int m = 0; m < 4; ++m)
#pragma unroll
          for (int n = 0; n < 2; ++n) acc[a][b][m][n] = (f32x4){0.f, 0.f, 0.f, 0.f};
    cur = nxt; cA = nA; cB = nB; ++ui;
  }
  PG8_WAIT_V(0);
  if (wr == 0) PG8_BAR;
  PG8_BAR;
#undef PG8_SA
#undef PG8_SB
#undef PG8_STAGE
#undef PG8_LDA
#undef PG8_LDB
#undef PG8_MMA
#undef PG8_WAIT_V
#undef PG8_WAIT_L
#undef PG8_BAR
#undef PG8_SCHED
}

template <class Epi>
__device__ __forceinline__ void gemm_phase_gather(LAS unsigned char* lds, const Gemm g, const int* __restrict__ rowidx, const Sched& S, const Epi& E) {
  const int tid = opaque_tid(), wid = __builtin_amdgcn_readfirstlane(tid >> 6), lane = tid & 63, wr = wid >> 2, wc = wid & 3, fr = lane & 15, fq = lane >> 4;
  const int K = g.K, nt = K / BK;
  unsigned voffB[2]; int Rr[2], Cc[2];
#pragma unroll
  for (int i = 0; i < 2; ++i) { int R, C; stage_rc(tid * 16 + i * 8192, R, C); const int Rb = Epi::PERM ? ((R & ~31) + perm32(R & 31)) : R;
    Rr[i] = R; Cc[i] = C; voffB[i] = (unsigned)(Rb * g.ldb + C) * 2u; }
  unsigned vc0[2], vc1[2], vn0[2], vn1[2];
#define PG8_ROWOFF(v0, v1, u) do { _Pragma("unroll") for (int _i = 0; _i < 2; ++_i) { \
    v0[_i] = (unsigned)(rowidx[(u).pm * 256 + Rr[_i]] * g.lda + Cc[_i]) * 2u; v1[_i] = (unsigned)(rowidx[(u).pm * 256 + 128 + Rr[_i]] * g.lda + Cc[_i]) * 2u; } } while (0)
  const size_t kstep = (size_t)(BK * 2);
  const size_t hstepB = (size_t)HALF * g.ldb * 2;
  const size_t tstepB = 2 * hstepB;
  const unsigned ldsw = (unsigned)wid * 1024u;
  const int aoff = lds_byte(wr * 64 + fr, fq * 8), boff = lds_byte(wc * 32 + fr, fq * 8);
#define PG8_SA(b, h) (((b) * 2 + (h)) * HTB)
#define PG8_SB(b, h) ((4 + (b) * 2 + (h)) * HTB)
#define PG8_STAGE(bufoff, gbase, voff) do { _Pragma("unroll") for (int _i = 0; _i < 2; ++_i) \
    __builtin_amdgcn_global_load_lds((const unsigned*)((const char*)(gbase) + (voff)[_i]), (LAS unsigned*)(lds + (bufoff) + ldsw + _i * 8192), 16, 0, 0); } while (0)
#define PG8_LDA(dst, b, h) do { _Pragma("unroll") for (int m = 0; m < 4; ++m) _Pragma("unroll") for (int k = 0; k < 2; ++k) dst[m][k] = *(const LAS bf16x8*)(lds + PG8_SA(b, h) + aoff + m * 2048 + k * 1024); } while (0)
#define PG8_LDB(dst, b, h) do { _Pragma("unroll") for (int n = 0; n < 2; ++n) _Pragma("unroll") for (int k = 0; k < 2; ++k) dst[n][k] = *(const LAS bf16x8*)(lds + PG8_SB(b, h) + boff + n * 2048 + k * 1024); } while (0)
#define PG8_MMA(ai, bj, At, Bt) do { __builtin_amdgcn_s_setprio(1); _Pragma("unroll") for (int m = 0; m < 4; ++m) _Pragma("unroll") for (int n = 0; n < 2; ++n) _Pragma("unroll") for (int k = 0; k < 2; ++k) \
    acc[ai][bj][m][n] = __builtin_amdgcn_mfma_f32_16x16x32_bf16(Bt[n][k], At[m][k], acc[ai][bj][m][n], 0, 0, 0); __builtin_amdgcn_s_setprio(0); } while (0)
#define PG8_WAIT_V(n) asm volatile("s_waitcnt vmcnt(" #n ")" ::: "memory")
#define PG8_WAIT_L(n) asm volatile("s_waitcnt lgkmcnt(" #n ")" ::: "memory")
#define PG8_BAR __builtin_amdgcn_s_barrier()
#define PG8_SCHED __builtin_amdgcn_sched_barrier(0)
  Unit cur, nxt; int ui = 0;
  if (!S.next(0, cur)) return;
  f32x4 acc[2][2][4][2];
#pragma unroll
  for (int a = 0; a < 2; ++a)
#pragma unroll
    for (int b = 0; b < 2; ++b)
#pragma unroll
      for (int m = 0; m < 4; ++m)
#pragma unroll
        for (int n = 0; n < 2; ++n) acc[a][b][m][n] = (f32x4){0.f, 0.f, 0.f, 0.f};
  bf16x8 At[4][2], B0[2][2], B1[2][2];
  const char* cA = (const char*)g.A; const char* cB = (const char*)g.Bt + (size_t)cur.pn * tstepB;
  PG8_ROWOFF(vc0, vc1, cur);
  PG8_STAGE(PG8_SB(0, 0), cB, voffB); PG8_STAGE(PG8_SA(0, 0), cA, vc0); PG8_STAGE(PG8_SB(0, 1), cB + hstepB, voffB); PG8_STAGE(PG8_SA(0, 1), cA, vc1);
  if (wr == 1) PG8_BAR;
  PG8_WAIT_V(4); PG8_BAR;
  PG8_STAGE(PG8_SB(1, 0), cB + kstep, voffB); PG8_STAGE(PG8_SA(1, 0), cA + kstep, vc0); PG8_STAGE(PG8_SB(1, 1), cB + hstepB + kstep, voffB);
  PG8_WAIT_V(6); PG8_BAR;
  for (;;) {
    const bool has_next = S.next(ui + 1, nxt);
    const char* nB = has_next ? (const char*)g.Bt + (size_t)nxt.pn * tstepB : cB;
    if (has_next) PG8_ROWOFF(vn0, vn1, nxt); else { vn0[0] = vc0[0]; vn0[1] = vc0[1]; vn1[0] = vc1[0]; vn1[1] = vc1[1]; }
    for (int t = 0; t < nt; t += 2) {
      const bool last = (t == nt - 2);
      const char* a1 = cA + (size_t)(t + 1) * kstep;
      const char* a2 = last ? cA : cA + (size_t)(t + 2) * kstep; const char* b2 = last ? nB : cB + (size_t)(t + 2) * kstep;
      unsigned s0[2], s1[2]; s0[0] = last ? vn0[0] : vc0[0]; s0[1] = last ? vn0[1] : vc0[1]; s1[0] = last ? vn1[0] : vc1[0]; s1[1] = last ? vn1[1] : vc1[1];
      const char* a3 = a2 + kstep; const char* b3 = b2 + kstep;
      PG8_LDB(B0, 0, 0); PG8_SCHED; PG8_LDA(At, 0, 0); PG8_STAGE(PG8_SA(1, 1), a1, vc1);
      PG8_WAIT_L(8); PG8_BAR; PG8_WAIT_L(0); PG8_MMA(0, 0, At, B0); PG8_BAR; PG8_SCHED;
      PG8_LDB(B1, 0, 1); PG8_STAGE(PG8_SB(0, 0), b2, voffB);
      PG8_BAR; PG8_WAIT_L(0); PG8_MMA(0, 1, At, B1); PG8_BAR;
      PG8_LDA(At, 0, 1); PG8_STAGE(PG8_SA(0, 0), a2, s0);
      PG8_BAR; PG8_WAIT_L(0); PG8_MMA(1, 0, At, B0); PG8_BAR; PG8_SCHED;
      PG8_STAGE(PG8_SB(0, 1), b2 + hstepB, voffB);
      PG8_WAIT_V(6); PG8_BAR; PG8_MMA(1, 1, At, B1); PG8_BAR;
      PG8_LDB(B0, 1, 0); PG8_SCHED; PG8_LDA(At, 1, 0); PG8_STAGE(PG8_SA(0, 1), a2, s1);
      PG8_WAIT_L(8); PG8_BAR; PG8_WAIT_L(0); PG8_MMA(0, 0, At, B0); PG8_BAR; PG8_SCHED;
      PG8_LDB(B1, 1, 1); PG8_STAGE(PG8_SB(1, 0), b3, voffB);
      PG8_BAR; PG8_WAIT_L(0); PG8_MMA(0, 1, At, B1); PG8_BAR;
      PG8_LDA(At, 1, 1); PG8_STAGE(PG8_SA(1, 0), a3, s0);
      PG8_BAR; PG8_WAIT_L(0); PG8_MMA(1, 0, At, B0); PG8_BAR; PG8_SCHED;
      PG8_STAGE(PG8_SB(1, 1), b3 + hstepB, voffB);
      PG8_WAIT_V(6); PG8_BAR; PG8_MMA(1, 1, At, B1); PG8_BAR;
    }
    E(acc, cur, wr, wc, fr, fq);
#if defined(DUP_MASK)
    if (DUP_MASK & 8192) E(acc, cur, wr, wc, fr, fq);
#endif
    if (!has_next) break;
#pragma unroll
    for (int a = 0; a < 2; ++a)
#pragma unroll
      for (int b = 0; b < 2; ++b)
#pragma unroll
        for (int m = 0; m < 4; ++m)
#pragma unroll
          for (int n = 0; n < 2; ++n) acc[a][b][m][n] = (f32x4){0.f, 0.f, 0.f, 0.f};
    cur = nxt; cB = nB; ++ui; vc0[0] = vn0[0]; vc0[1] = vn0[1]; vc1[0] = vn1[0]; vc1[1] = vn1[1];
  }
  PG8_WAIT_V(0);
  if (wr == 0) PG8_BAR;
  PG8_BAR;
#undef PG8_ROWOFF
#undef PG8_SA
#undef PG8_SB
#undef PG8_STAGE
#undef PG8_LDA
#undef PG8_LDB
#undef PG8_MMA
#undef PG8_WAIT_V
#undef PG8_WAIT_L
#undef PG8_BAR
#undef PG8_SCHED
}

struct EpiBf16 {
  static constexpr bool PERM = true;
  bf16_t* O; int ldc;
  __device__ __forceinline__ void operator()(const f32x4 (&acc)[2][2][4][2], const Unit& u, int wr, int wc, int fr, int fq) const {
    const int row0 = u.pm * BM + wr * 64 + fr, col0 = u.pn * BM + wc * 32 + 8 * fq;
#pragma unroll
    for (int ai = 0; ai < 2; ++ai)
#pragma unroll
      for (int m = 0; m < 4; ++m) { bf16_t* rowp = O + (size_t)(row0 + ai * HALF + m * 16) * ldc + col0;
#pragma unroll
        for (int bj = 0; bj < 2; ++bj) { const f32x4 v0 = acc[ai][bj][m][0], v1 = acc[ai][bj][m][1];
          u32x4 w; w.x = cvt_pk_bf16(v0[0], v0[1]); w.y = cvt_pk_bf16(v0[2], v0[3]); w.z = cvt_pk_bf16(v1[0], v1[1]); w.w = cvt_pk_bf16(v1[2], v1[3]);
          *(u32x4*)(rowp + bj * HALF) = w; } }
  }
};
struct EpiYT {
  static constexpr bool PERM = true;
  bf16_t* YT; bf16_t* YTC;
  __device__ __forceinline__ void operator()(const f32x4 (&acc)[2][2][4][2], const Unit& u, int wr, int wc, int fr, int fq) const {
    const bool lat = u.pn < 64;
    const int b = lat ? (u.pn >> 3) : (u.pn - 64);
    const int tb = (lat ? (u.pn & 7) * 256 : 0) + wc * 32 + 8 * fq;
    const int nseq = lat ? 2048 : 256;
    bf16_t* base = lat ? YT : YTC;
#pragma unroll
    for (int ai = 0; ai < 2; ++ai)
#pragma unroll
      for (int m = 0; m < 4; ++m) { const int hl = ai * HALF + wr * 64 + m * 16 + fr;
        bf16_t* rowp = base + (size_t)(b * 256 + hl) * nseq + tb;
#pragma unroll
        for (int bj = 0; bj < 2; ++bj) { const f32x4 v0 = acc[ai][bj][m][0], v1 = acc[ai][bj][m][1];
          u32x4 w; w.x = cvt_pk_bf16(v0[0], v0[1]); w.y = cvt_pk_bf16(v0[2], v0[3]); w.z = cvt_pk_bf16(v1[0], v1[1]); w.w = cvt_pk_bf16(v1[2], v1[3]);
          *(u32x4*)(rowp + bj * HALF) = w; } }
  }
};
struct EpiDft {
  static constexpr bool PERM = true;
  bf16_t* CAT; int tok0, nseq; float scale;
  __device__ __forceinline__ void operator()(const f32x4 (&acc)[2][2][4][2], const Unit& u, int wr, int wc, int fr, int fq) const {
    const int row0 = tok0 + u.pn * nseq + u.pm * BM + wr * 64 + fr, col0 = wc * 32 + 8 * fq;
#pragma unroll
    for (int ai = 0; ai < 2; ++ai)
#pragma unroll
      for (int m = 0; m < 4; ++m) { bf16_t* rowp = CAT + (size_t)(row0 + ai * HALF + m * 16) * 1024 + col0;
#pragma unroll
        for (int bj = 0; bj < 2; ++bj) { const f32x4 v0 = acc[ai][bj][m][0] * scale, v1 = acc[ai][bj][m][1] * scale;
          u32x4 w; w.x = cvt_pk_bf16(v0[0], v0[1]); w.y = cvt_pk_bf16(v0[2], v0[3]); w.z = cvt_pk_bf16(v1[0], v1[1]); w.w = cvt_pk_bf16(v1[2], v1[3]);
          *(u32x4*)(rowp + bj * HALF) = w; } }
  }
};
struct EpiDft2 {
  static constexpr bool PERM = true;
  bf16_t* CAT; float scale;
  __device__ __forceinline__ void operator()(const f32x4 (&acc)[2][2][4][2], const Unit& u, int wr, int wc, int fr, int fq) const {
    const int rowb = (u.pn >> 3) * SEQ + (u.pn & 7), k20 = wr * 64 + fr, col0 = wc * 32 + 8 * fq;
#pragma unroll
    for (int ai = 0; ai < 2; ++ai)
#pragma unroll
      for (int m = 0; m < 4; ++m) { bf16_t* rowp = CAT + (size_t)(rowb + 8 * (k20 + ai * HALF + m * 16)) * 1024 + col0;
#pragma unroll
        for (int bj = 0; bj < 2; ++bj) { const f32x4 v0 = acc[ai][bj][m][0] * scale, v1 = acc[ai][bj][m][1] * scale;
          u32x4 w; w.x = cvt_pk_bf16(v0[0], v0[1]); w.y = cvt_pk_bf16(v0[2], v0[3]); w.z = cvt_pk_bf16(v1[0], v1[1]); w.w = cvt_pk_bf16(v1[2], v1[3]);
          *(u32x4*)(rowp + bj * HALF) = w; } }
  }
};
struct EpiOut {
  static constexpr bool PERM = true;
  const bf16_t* X; bf16_t* XMID; const float* modl;
  __device__ __forceinline__ void operator()(const f32x4 (&acc)[2][2][4][2], const Unit& u, int wr, int wc, int fr, int fq) const {
    const int row0 = u.pm * BM + wr * 64 + fr, col0 = u.pn * BM + wc * 32 + 8 * fq;
    const int s = u.pm < 64 ? (u.pm >> 3) : 8;
    const float* g1 = modl + (size_t)s * 6144 + 2048 + col0;
    f32x4 gv[2][2];
#pragma unroll
    for (int bj = 0; bj < 2; ++bj)
#pragma unroll
      for (int n = 0; n < 2; ++n) gv[bj][n] = *(const f32x4*)(g1 + bj * HALF + n * 4);
#pragma unroll
    for (int ai = 0; ai < 2; ++ai)
#pragma unroll
      for (int m = 0; m < 4; ++m) { const size_t off = (size_t)(row0 + ai * HALF + m * 16) * 1024 + col0;
#pragma unroll
        for (int bj = 0; bj < 2; ++bj) { const u32x4 xw = *(const u32x4*)(X + off + bj * HALF);
          const f32x4 x0 = (f32x4){__uint_as_float(xw.x << 16), __uint_as_float(xw.x & 0xffff0000u), __uint_as_float(xw.y << 16), __uint_as_float(xw.y & 0xffff0000u)};
          const f32x4 x1 = (f32x4){__uint_as_float(xw.z << 16), __uint_as_float(xw.z & 0xffff0000u), __uint_as_float(xw.w << 16), __uint_as_float(xw.w & 0xffff0000u)};
          const f32x4 v0 = x0 + gv[bj][0] * acc[ai][bj][m][0], v1 = x1 + gv[bj][1] * acc[ai][bj][m][1];
          u32x4 w; w.x = cvt_pk_bf16(v0[0], v0[1]); w.y = cvt_pk_bf16(v0[2], v0[3]); w.z = cvt_pk_bf16(v1[0], v1[1]); w.w = cvt_pk_bf16(v1[2], v1[3]);
          *(u32x4*)(XMID + off + bj * HALF) = w; }
        asm volatile("" ::: "memory"); }
  }
};
struct EpiMoe1 {
  static constexpr bool PERM = true;
  bf16_t* HH;
  __device__ __forceinline__ void operator()(const f32x4 (&acc)[2][2][4][2], const Unit& u, int wr, int wc, int fr, int fq) const {
    const int row0 = u.pm * BM + wr * 64 + fr, col0 = (u.pn & 7) * 128 + wc * 32 + 8 * fq;
#pragma unroll
    for (int ai = 0; ai < 2; ++ai)
#pragma unroll
      for (int m = 0; m < 4; ++m) { bf16_t* rowp = HH + (size_t)(row0 + ai * HALF + m * 16) * 1024 + col0;
        float h[8];
#pragma unroll
        for (int n = 0; n < 2; ++n)
#pragma unroll
          for (int j = 0; j < 4; ++j) { const float a = acc[ai][0][m][n][j], uu = acc[ai][1][m][n][j];
            h[n * 4 + j] = a * __builtin_amdgcn_rcpf(1.f + __expf(-a)) * uu; }
        u32x4 w; w.x = cvt_pk_bf16(h[0], h[1]); w.y = cvt_pk_bf16(h[2], h[3]); w.z = cvt_pk_bf16(h[4], h[5]); w.w = cvt_pk_bf16(h[6], h[7]);
        *(u32x4*)rowp = w; }
  }
};
struct EpiMoe2 {
  static constexpr bool PERM = true;
  bf16_t* YY; const float* gate;
  __device__ __forceinline__ void operator()(const f32x4 (&acc)[2][2][4][2], const Unit& u, int wr, int wc, int fr, int fq) const {
    const int row0 = u.pm * BM + wr * 64 + fr, col0 = (u.pn & 3) * BM + wc * 32 + 8 * fq;
#pragma unroll
    for (int ai = 0; ai < 2; ++ai)
#pragma unroll
      for (int m = 0; m < 4; ++m) { const int row = row0 + ai * HALF + m * 16; const float gt = gate[row];
        bf16_t* rowp = YY + (size_t)row * 1024 + col0;
#pragma unroll
        for (int bj = 0; bj < 2; ++bj) { const f32x4 v0 = acc[ai][bj][m][0] * gt, v1 = acc[ai][bj][m][1] * gt;
          u32x4 w; w.x = cvt_pk_bf16(v0[0], v0[1]); w.y = cvt_pk_bf16(v0[2], v0[3]); w.z = cvt_pk_bf16(v1[0], v1[1]); w.w = cvt_pk_bf16(v1[2], v1[3]);
          *(u32x4*)(rowp + bj * HALF) = w; } }
  }
};
}

namespace att {
constexpr int D = 128, QBLK = 32, KVBLK = 64;
constexpr float SCALE = 0.088388347648318440f;
constexpr float THR = 8.f;
constexpr int LDQ = 1280, LDK = 256, LDO = 1024;
constexpr size_t SHM_V = KVBLK * D * 2, SHM_K = KVBLK * D * 2, SHM_ATTN = 2 * SHM_V + 2 * SHM_K + 8 * 64 * 4;
#define KSWZ(row, colB) ((row) * 256 + ((colB) ^ (((row) & 7) << 4)))
#define SBAR() __builtin_amdgcn_sched_barrier(0)
__device__ __forceinline__ int crow(int r, int hi) { return (r & 3) + 8 * (r >> 2) + 4 * hi; }
__device__ __forceinline__ void partialSM(f32x16& p0, f32x16& p1, float& m_reg, float& mn, float& alpha) {
  constexpr float C = SCALE * 1.4426950408889634f;
  float pmax = p0[0];
#pragma unroll
  for (int r = 1; r < 16; ++r) pmax = fmaxf(pmax, p0[r]);
#pragma unroll
  for (int r = 0; r < 16; ++r) pmax = fmaxf(pmax, p1[r]);
  { auto rr = __builtin_amdgcn_permlane32_swap(__float_as_uint(pmax), __float_as_uint(pmax), false, false);
    pmax = fmaxf(__uint_as_float(rr[0]), __uint_as_float(rr[1])); }
  if (__builtin_expect(__all(pmax - m_reg <= THR / SCALE), 1)) { mn = m_reg; alpha = 1.f; }
  else { mn = fmaxf(m_reg, pmax); alpha = __builtin_amdgcn_exp2f((m_reg - mn) * C); m_reg = mn; }
  float mnC = -mn * C;
#pragma unroll
  for (int r = 0; r < 16; ++r) p0[r] = fmaf(p0[r], C, mnC);
#pragma unroll
  for (int r = 0; r < 16; ++r) p1[r] = fmaf(p1[r], C, mnC);
#pragma unroll
  for (int r = 0; r < 16; ++r) p0[r] = __builtin_amdgcn_exp2f(p0[r]);
}
__device__ __forceinline__ void finishSM(f32x16& p0, f32x16& p1, float alpha, float& l_reg, bf16x8& pa0, bf16x8& pa1, bf16x8& pa2, bf16x8& pa3) {
#pragma unroll
  for (int r = 0; r < 16; ++r) p1[r] = __builtin_amdgcn_exp2f(p1[r]);
  float ps = 0;
#pragma unroll
  for (int r = 0; r < 16; ++r) ps += p0[r];
#pragma unroll
  for (int r = 0; r < 16; ++r) ps += p1[r];
  { auto rr = __builtin_amdgcn_permlane32_swap(__float_as_uint(ps), __float_as_uint(ps), false, false);
    ps = __uint_as_float(rr[0]) + __uint_as_float(rr[1]); }
  l_reg = l_reg * alpha + ps;
#define PK4(P, BASE, OUT) do { unsigned a0 = cvt_pk_bf16(P[BASE + 0], P[BASE + 1]), a1 = cvt_pk_bf16(P[BASE + 2], P[BASE + 3]);   \
    unsigned b0 = cvt_pk_bf16(P[BASE + 4], P[BASE + 5]), b1 = cvt_pk_bf16(P[BASE + 6], P[BASE + 7]);                              \
    auto r0 = __builtin_amdgcn_permlane32_swap(a0, b0, false, false); auto r1 = __builtin_amdgcn_permlane32_swap(a1, b1, false, false); \
    u32x4 w = {r0[0], r1[0], r0[1], r1[1]}; OUT = *reinterpret_cast<bf16x8*>(&w); } while (0)
  PK4(p0, 0, pa0); PK4(p0, 8, pa1); PK4(p1, 0, pa2); PK4(p1, 8, pa3);
#undef PK4
}
__device__ __forceinline__ void qkt(f32x16& p0, f32x16& p1, const bf16_t* Ks, const bf16x8* qr, int r32, int hi) {
  p0 = f32x16{}; p1 = f32x16{};
#pragma unroll
  for (int d0 = 0; d0 < 8; ++d0) { int cb = (d0 * 16 + hi * 8) * 2;
    bf16x8 b0 = *reinterpret_cast<const bf16x8*>((const char*)Ks + KSWZ(r32, cb));
    bf16x8 b1 = *reinterpret_cast<const bf16x8*>((const char*)Ks + KSWZ(32 + r32, cb));
    p0 = __builtin_amdgcn_mfma_f32_32x32x16_bf16(b0, qr[d0], p0, 0, 0, 0);
    p1 = __builtin_amdgcn_mfma_f32_32x32x16_bf16(b1, qr[d0], p1, 0, 0, 0); }
}
__device__ __forceinline__ int v_st(int k, int c) { const int kk = (k & ~0xC) | ((k & 4) << 1) | ((k & 8) >> 1); return ((kk >> 3) * 4 + (c >> 5)) * 512 + ((kk & 7) * 32 + (c & 31)) * 2; }
__device__ __forceinline__ int v_rd_base(int lane) { return ((lane & 3) << 3) | (((lane >> 2) & 3) << 6) | (((lane >> 4) & 1) << 5) | (((lane >> 5) & 1) << 8); }
constexpr int v_rd_off(int d0, int ks, int half) { return d0 * 512 + ks * 4096 + half * 2048; }
template <int OFF> __device__ __forceinline__ s16x4 tr_read(int vb) {
  s16x4 r; asm volatile("ds_read_b64_tr_b16 %0, %1 offset:%2" : "=&v"(r) : "v"(vb), "i"(OFF) : "memory"); return r;
}
template <int D0> __device__ __forceinline__ void pv_one(f32x16& od, int vb, bf16x8 pa0, bf16x8 pa1, bf16x8 pa2, bf16x8 pa3) {
  const s16x4 l0 = tr_read<v_rd_off(D0, 0, 0)>(vb), h0 = tr_read<v_rd_off(D0, 0, 1)>(vb), l1 = tr_read<v_rd_off(D0, 1, 0)>(vb), h1 = tr_read<v_rd_off(D0, 1, 1)>(vb);
  const s16x4 l2 = tr_read<v_rd_off(D0, 2, 0)>(vb), h2 = tr_read<v_rd_off(D0, 2, 1)>(vb), l3 = tr_read<v_rd_off(D0, 3, 0)>(vb), h3 = tr_read<v_rd_off(D0, 3, 1)>(vb);
  asm volatile("s_waitcnt lgkmcnt(0)" ::: "memory"); SBAR();
#define PK(L, H) (bf16x8){L[0], L[1], L[2], L[3], H[0], H[1], H[2], H[3]}
  od = __builtin_amdgcn_mfma_f32_32x32x16_bf16(pa0, PK(l0, h0), od, 0, 0, 0);
  od = __builtin_amdgcn_mfma_f32_32x32x16_bf16(pa1, PK(l1, h1), od, 0, 0, 0);
  od = __builtin_amdgcn_mfma_f32_32x32x16_bf16(pa2, PK(l2, h2), od, 0, 0, 0);
  od = __builtin_amdgcn_mfma_f32_32x32x16_bf16(pa3, PK(l3, h3), od, 0, 0, 0);
#undef PK
}
__device__ __forceinline__ void pv_d0(f32x16* o, int vb, bf16x8 pa0, bf16x8 pa1, bf16x8 pa2, bf16x8 pa3) {
  pv_one<0>(o[0], vb, pa0, pa1, pa2, pa3); pv_one<1>(o[1], vb, pa0, pa1, pa2, pa3); pv_one<2>(o[2], vb, pa0, pa1, pa2, pa3); pv_one<3>(o[3], vb, pa0, pa1, pa2, pa3);
}
__device__ __forceinline__ void attn_dense_body(const bf16_t* __restrict__ Qb, const bf16_t* __restrict__ Kh, const bf16_t* __restrict__ Vh,
                                                bf16_t* __restrict__ Ob, int seq, char* lds, const float* __restrict__ qg, const float* __restrict__ RC, const float* __restrict__ RS, const bool rope, const int tpos) {
  const int tid = opaque_tid(), wid = tid >> 6, lane = tid & 63, r32 = lane & 31, hi = lane >> 5;
  bf16_t* V_lds = (bf16_t*)lds; bf16_t* K_lds = (bf16_t*)(lds + 2 * SHM_V);
  float* wsl = (float*)(lds + 2 * SHM_V + 2 * SHM_K) + wid * 64; float* li_l = wsl; float* al_l = wsl + 32;
  float m_reg = -1e30f, l_reg = 0; f32x16 o[4] = {}; bf16x8 qr[8];
  const bf16_t* Qw = Qb + (long)(wid * QBLK + r32) * LDQ + hi * 8;
  { float f[8][8]; float ss = 0.f;
#pragma unroll
    for (int d0 = 0; d0 < 8; ++d0) { const u32x4 w = *reinterpret_cast<const u32x4*>(Qw + d0 * 16);
      f[d0][0] = __uint_as_float(w.x << 16); f[d0][1] = __uint_as_float(w.x & 0xffff0000u); f[d0][2] = __uint_as_float(w.y << 16); f[d0][3] = __uint_as_float(w.y & 0xffff0000u);
      f[d0][4] = __uint_as_float(w.z << 16); f[d0][5] = __uint_as_float(w.z & 0xffff0000u); f[d0][6] = __uint_as_float(w.w << 16); f[d0][7] = __uint_as_float(w.w & 0xffff0000u);
#pragma unroll
      for (int j = 0; j < 8; ++j) ss += f[d0][j] * f[d0][j]; }
    ss += __shfl_xor(ss, 32);
    const float rn = rsqrtf(ss * (1.f / 128.f) + EPS);
#pragma unroll
    for (int d0 = 0; d0 < 8; ++d0) { const f32x4 g0 = *(const f32x4*)(qg + d0 * 16 + hi * 8), g1 = *(const f32x4*)(qg + d0 * 16 + hi * 8 + 4);
#pragma unroll
      for (int j = 0; j < 4; ++j) { f[d0][j] *= rn * g0[j]; f[d0][4 + j] *= rn * g1[j]; } }
    if (rope) { const int t = tpos + wid * QBLK + r32;
#pragma unroll
      for (int blk = 0; blk < 2; ++blk) { const int pos = blk ? (t & 63) : (t >> 6);
#pragma unroll
        for (int q = 0; q < 2; ++q) { const int o = pos * 32 + q * 16 + hi * 8;
          const f32x4 c0 = *(const f32x4*)(RC + o), c1 = *(const f32x4*)(RC + o + 4), s0 = *(const f32x4*)(RS + o), s1 = *(const f32x4*)(RS + o + 4);
#pragma unroll
          for (int j = 0; j < 8; ++j) { const float cs = j < 4 ? c0[j & 3] : c1[j & 3], sn = j < 4 ? s0[j & 3] : s1[j & 3];
            const float x1 = f[4 * blk + q][j], x2 = f[4 * blk + q + 2][j]; f[4 * blk + q][j] = x1 * cs - x2 * sn; f[4 * blk + q + 2][j] = x2 * cs + x1 * sn; } } } }
#pragma unroll
    for (int d0 = 0; d0 < 8; ++d0) { u32x4 w; w.x = cvt_pk_bf16(f[d0][0], f[d0][1]); w.y = cvt_pk_bf16(f[d0][2], f[d0][3]); w.z = cvt_pk_bf16(f[d0][4], f[d0][5]); w.w = cvt_pk_bf16(f[d0][6], f[d0][7]);
      qr[d0] = *reinterpret_cast<bf16x8*>(&w); } }
  const int sr = tid >> 4, sc = (tid & 15) * 8, vst0 = v_st(sr, sc), vst1 = v_st(32 + sr, sc);
  const int vb0 = (int)(uintptr_t)V_lds + v_rd_base(lane);
  struct { bf16x8 vs0, vs1, ks0, ks1; } sr_[2];
#define SLOAD(i, k0) do { sr_[i].vs0 = *reinterpret_cast<const bf16x8*>(&Vh[(long)((k0) + sr) * LDK + sc]); sr_[i].vs1 = *reinterpret_cast<const bf16x8*>(&Vh[(long)((k0) + 32 + sr) * LDK + sc]); \
    sr_[i].ks0 = *reinterpret_cast<const bf16x8*>(&Kh[(long)((k0) + sr) * LDK + sc]); sr_[i].ks1 = *reinterpret_cast<const bf16x8*>(&Kh[(long)((k0) + 32 + sr) * LDK + sc]); } while (0)
#define SWRITE(b, i) do { *(bf16x8*)((char*)V_lds + (b) * SHM_V + vst0) = sr_[i].vs0;          \
    *(bf16x8*)((char*)V_lds + (b) * SHM_V + vst1) = sr_[i].vs1; int kc = sc * 2;               \
    *(bf16x8*)((char*)K_lds + (b) * SHM_K + KSWZ(sr, kc)) = sr_[i].ks0;                       \
    *(bf16x8*)((char*)K_lds + (b) * SHM_K + KSWZ(32 + sr, kc)) = sr_[i].ks1; } while (0)
#define SWAIT() asm volatile("s_waitcnt vmcnt(4)" ::: "memory")
#define RESC(a) do { if (__any((a) < 1.f)) { if (hi == 0) al_l[r32] = (a); asm volatile("s_waitcnt lgkmcnt(0)" ::: "memory"); \
    _Pragma("unroll") for (int d = 0; d < 4; ++d) _Pragma("unroll") for (int r = 0; r < 16; ++r) o[d][r] *= al_l[crow(r, hi)]; } } while (0)
  f32x16 pA0, pA1, pB0, pB1; float mnA, mnB, alA, alB; bf16x8 pa0, pa1, pa2, pa3; const int NT = seq / KVBLK;
  constexpr int SE = 0, SO = 1;
  SLOAD(SE, 0); asm volatile("s_waitcnt vmcnt(0)" ::: "memory"); SWRITE(0, SE); __syncthreads();
  qkt(pA0, pA1, K_lds, qr, r32, hi); partialSM(pA0, pA1, m_reg, mnA, alA);
  SLOAD(SO, KVBLK); if (2 < NT) SLOAD(SE, 2 * KVBLK);
  SWAIT(); SWRITE(1, SO); __syncthreads();
  for (int j = 1; j + 1 < NT; j += 2) {
    SBAR(); qkt(pB0, pB1, (bf16_t*)((char*)K_lds + SHM_K), qr, r32, hi);
    finishSM(pA0, pA1, alA, l_reg, pa0, pa1, pa2, pa3); SBAR();
    SLOAD(SO, (j + 2) * KVBLK); SBAR();
    pv_d0(o, vb0, pa0, pa1, pa2, pa3); partialSM(pB0, pB1, m_reg, mnB, alB);
    __syncthreads(); SWAIT(); SWRITE(0, SE);
    RESC(alB); __syncthreads();
    SBAR(); qkt(pA0, pA1, K_lds, qr, r32, hi);
    finishSM(pB0, pB1, alB, l_reg, pa0, pa1, pa2, pa3); SBAR();
    if (j + 3 < NT) SLOAD(SE, (j + 3) * KVBLK); SBAR();
    pv_d0(o, vb0 + (int)SHM_V, pa0, pa1, pa2, pa3); partialSM(pA0, pA1, m_reg, mnA, alA);
    __syncthreads(); SWAIT(); SWRITE(1, SO);
    RESC(alA); __syncthreads();
  }
  SBAR(); qkt(pB0, pB1, (bf16_t*)((char*)K_lds + SHM_K), qr, r32, hi);
  finishSM(pA0, pA1, alA, l_reg, pa0, pa1, pa2, pa3); SBAR();
  pv_d0(o, vb0, pa0, pa1, pa2, pa3); partialSM(pB0, pB1, m_reg, mnB, alB);
  __syncthreads(); RESC(alB);
  finishSM(pB0, pB1, alB, l_reg, pa0, pa1, pa2, pa3); SBAR();
  pv_d0(o, vb0 + (int)SHM_V, pa0, pa1, pa2, pa3);
  if (hi == 0) li_l[r32] = l_reg; asm volatile("s_waitcnt lgkmcnt(0)" ::: "memory");
  float rli[16];
#pragma unroll
  for (int r = 0; r < 16; ++r) rli[r] = __builtin_amdgcn_rcpf(li_l[crow(r, hi)]);
  bf16_t* Ow = Ob + (long)(wid * QBLK) * LDO;
#pragma unroll
  for (int r = 0; r < 16; ++r) { int orow = crow(r, hi);
#pragma unroll
    for (int d0 = 0; d0 < 4; ++d0) Ow[(long)orow * LDO + d0 * 32 + r32] = f2bf(o[d0][r] * rli[r]); }
  __syncthreads();
#undef SLOAD
#undef SWRITE
#undef SWAIT
#undef RESC
}
}

__device__ __forceinline__ void transpose_item(const float* W, int ldw, int k0, int n0, bf16_t* dst, int dld, int drow0, int dcol0, LAS float* scr, int lane) {
  const int kq = lane >> 3, n4 = (lane & 7) * 4;
  f32x4 v[8];
#pragma unroll
  for (int i = 0; i < 8; ++i) v[i] = __builtin_nontemporal_load((const f32x4*)(W + (size_t)(k0 + i * 8 + kq) * ldw + n0 + n4));
#pragma unroll
  for (int i = 0; i < 8; ++i) { LAS float* d = scr + (i * 8 + kq) * 33 + n4; d[0] = v[i][0]; d[1] = v[i][1]; d[2] = v[i][2]; d[3] = v[i][3]; }
  LDS_WAIT();
  const int c = lane & 7;
#pragma unroll
  for (int j = 0; j < 4; ++j) { const int n = (lane >> 3) + 8 * j; const LAS float* s = scr + (8 * c) * 33 + n;
    u32x4 o; o.x = cvt_pk_bf16(s[0 * 33], s[1 * 33]); o.y = cvt_pk_bf16(s[2 * 33], s[3 * 33]); o.z = cvt_pk_bf16(s[4 * 33], s[5 * 33]); o.w = cvt_pk_bf16(s[6 * 33], s[7 * 33]);
    *(u32x4*)(dst + (size_t)(drow0 + n) * dld + dcol0 + 8 * c) = o; }
  LDS_WAIT();
}

__device__ __forceinline__ void convert_moe_weights(int l, int rank, int nranks, int lo, int hi, LAS unsigned char* lds);
__device__ __forceinline__ void ph_prep(LAS unsigned char* lds) {
  CParams& p = *kargs();
  unsigned char* ws = p.ws;
  const int tid = opaque_tid(), lane = tid & 63, wave = tid >> 6, G = gridDim.x, bx = blockIdx.x;
#ifndef PREP_MASK
#define PREP_MASK 63
#endif
  if (PREP_MASK & 1) {
    LAS float* sc = (LAS float*)lds;
    LAS float* red = (LAS float*)(lds + 9 * 1024 * 4);
    for (int i = tid; i < 9 * 1024; i += NTHR) { const int s = i >> 10, k = i & 1023; const float v = s < 8 ? p.in[I_C][s * 1024 + k] : p.in[I_CCTX][k];
      sc[i] = v / (1.f + __expf(-v)); }
    __syncthreads();
    float* MOD = (float*)(ws + WS_MOD);
    typedef float f32x2v __attribute__((ext_vector_type(2)));
    for (int item = bx; item < 4 * 48; item += G) {
      const int l = item / 48, n0 = (item % 48) * 128;
      const float* w = p.in[I_ADAW] + (size_t)l * 1024 * 6144 + (size_t)(wave * 128) * 6144 + n0 + lane * 2;
      float acc[9][2];
#pragma unroll
      for (int s = 0; s < 9; ++s) { acc[s][0] = 0.f; acc[s][1] = 0.f; }
#pragma unroll 32
      for (int k = 0; k < 128; ++k) { const f32x2v wv = __builtin_nontemporal_load((const f32x2v*)(w + (size_t)k * 6144));
#pragma unroll
        for (int s = 0; s < 9; ++s) { const float a = sc[s * 1024 + wave * 128 + k]; acc[s][0] += a * wv.x; acc[s][1] += a * wv.y; } }
#pragma unroll
      for (int s = 0; s < 9; ++s) { red[(wave * 9 + s) * 128 + lane * 2] = acc[s][0]; red[(wave * 9 + s) * 128 + lane * 2 + 1] = acc[s][1]; }
      __syncthreads();
      for (int o = tid; o < 9 * 128; o += NTHR) { const int s = o >> 7, ln = o & 127; float t = 0.f;
#pragma unroll
        for (int ks = 0; ks < 8; ++ks) t += red[(ks * 9 + s) * 128 + ln];
        MOD[((size_t)l * 9 + s) * 6144 + n0 + ln] = t + p.in[I_ADAB][l * 6144 + n0 + ln]; }
      __syncthreads();
    }
    if (G == 256 && bx >= 192) convert_moe_weights(0, bx - 192, 64, 0, CONV_P, lds);
  }
  if ((PREP_MASK & 2) && bx == 0) {
    float* RC = (float*)(ws + WS_ROPE); float* RS = RC + 2048;
    for (int i = tid; i < 2048; i += NTHR) { const int pos = i >> 5, fi = i & 31;
      const float inv = exp2f(-(float)fi * (13.287712379549449f / 32.f));
      const float ang = (float)pos * inv;
      const double a = (double)ang; const double kk = rint(a * 0.15915494309189535); const float r = (float)(a - kk * 6.283185307179586);
      RC[i] = __cosf(r); RS[i] = __sinf(r); }
  }
  if (PREP_MASK & 4) {
    LAS float* tab = (LAS float*)(lds + 64 * 1024);
    for (int i = tid; i < 2048; i += NTHR) { const int m = i < 1024 ? i : i - 2048; tab[i] = __cosf((float)m * (6.283185307179586f / 2048.f)); }
    __syncthreads();
    bf16_t* DFTM = (bf16_t*)(ws + WS_DFTM);
    for (int it = bx * NTHR + tid; it < 256 * 512 / 8; it += G * NTHR) {
      const int k = it >> 6, j0 = (it & 63) * 8; unsigned w[4];
#pragma unroll
      for (int q = 0; q < 4; ++q) { float v[2];
#pragma unroll
        for (int h = 0; h < 2; ++h) { const int j = j0 + q * 2 + h; v[h] = j < 256 ? tab[(8 * k * j) & 2047] : -tab[(8 * k * (j - 256) + 512) & 2047]; }
        w[q] = cvt_pk_bf16(v[0], v[1]); }
      *(u32x4*)(DFTM + (size_t)it * 8) = (u32x4){w[0], w[1], w[2], w[3]};
    }
    bf16_t* DFTC = (bf16_t*)(ws + WS_DFTC);
    for (int it = bx * NTHR + tid; it < 256 * 256 / 8; it += G * NTHR) {
      const int k = it >> 5, j0 = (it & 31) * 8; unsigned w[4];
#pragma unroll
      for (int q = 0; q < 4; ++q) { float v[2];
#pragma unroll
        for (int h = 0; h < 2; ++h) { const int j = j0 + q * 2 + h; const int idx = j <= 128 ? (8 * k * j) & 2047 : (8 * k * (j - 128) + 512) & 2047; v[h] = tab[idx]; }
        w[q] = cvt_pk_bf16(v[0], v[1]); }
      *(u32x4*)(DFTC + (size_t)it * 8) = (u32x4){w[0], w[1], w[2], w[3]};
    }
    __syncthreads();
  }
  if (PREP_MASK & 8) {
    LAS float* Wt = (LAS float*)lds;
    LAS float* T = (LAS float*)(lds + 64 * 65 * 4);
    bf16_t* WF = (bf16_t*)(ws + WS_WF);
    for (int item = bx; item < 4 * 4 * 16; item += G) {
      const int l = item >> 6, h = (item >> 4) & 3, kc = item & 15;
      if (tid < 64) { T[tid] = __cosf((float)(tid < 32 ? tid : tid - 64) * (6.283185307179586f / 64.f)); T[64 + tid] = __sinf((float)(tid < 32 ? tid : tid - 64) * (6.283185307179586f / 64.f)); }
      { float tv[8];
#pragma unroll
        for (int q = 0; q < 8; ++q) { const int i = tid + q * NTHR, kk = i >> 6, c = i & 63; tv[q] = p.in[I_WIN][(size_t)l * 1024 * 1536 + (size_t)(kc * 64 + kk) * 1536 + h * 64 + c]; }
#pragma unroll
        for (int q = 0; q < 8; ++q) { const int i = tid + q * NTHR, kk = i >> 6, c = i & 63; Wt[kk * 65 + c] = tv[q]; } }
      __syncthreads();
      float wrow[64];
#pragma unroll
      for (int c = 0; c < 64; ++c) wrow[c] = Wt[lane * 65 + c];
#pragma unroll 1
      for (int jj = 0; jj < 8; ++jj) { const int jp = wave * 8 + jj, cs = jp >= 33 ? 1 : 0, lq = cs ? jp - 32 : jp; float a = 0.f;
        asm volatile("" ::: "memory");
#pragma unroll
        for (int c = 0; c < 64; ++c) a += wrow[c] * T[cs * 64 + ((lq * c) & 63)];
        WF[((size_t)l * 256 + h * 64 + jp) * 1024 + kc * 64 + lane] = f2bf(a); }
      __syncthreads();
    }
  }
  if (PREP_MASK & 16) {
    LAS float* As = (LAS float*)lds;
    LAS float* Bs = (LAS float*)(lds + 64 * 256 * 4);
    bf16_t* WO = (bf16_t*)(ws + WS_WO);
    for (int item = bx; item < 4 * 8 * 16; item += G) {
      const int l = item >> 7, kt = (item >> 4) & 7, ntile = item & 15;
      const int M = kt < 4 ? 256 : 64;
      const float* wout = p.in[I_WOUT] + (size_t)l * 1024 * 1024;
      if (kt < 4) {
        const float* wf = p.in[I_WFOU] + (size_t)l * 256 * 256 + (size_t)(kt * 64) * 256;
        { f32x4 ta[8], tb[8];
#pragma unroll
          for (int q = 0; q < 8; ++q) { const int i = tid + q * NTHR; ta[q] = *(const f32x4*)(wf + i * 4); const int m = i >> 4, n4 = (i & 15) * 4; tb[q] = *(const f32x4*)(wout + (size_t)m * 1024 + ntile * 64 + n4); }
#pragma unroll
          for (int q = 0; q < 8; ++q) { const int i = tid + q * NTHR; *(LAS f32x4*)(As + i * 4) = ta[q]; *(LAS f32x4*)(Bs + i * 4) = tb[q]; } }
      } else {
        const int g = kt - 4;
        const float* wp = p.in[I_WPOOL] + (size_t)l * 4 * 64 * 64 + (size_t)g * 64 * 64;
        const float* ps = p.in[I_PSCALE] + l * 256 + g * 64;
        { f32x4 ta[2], tb[2], tp[2];
#pragma unroll
          for (int q = 0; q < 2; ++q) { const int i = tid + q * NTHR; ta[q] = *(const f32x4*)(wp + i * 4); tp[q] = *(const f32x4*)(ps + (i & 15) * 4); const int m = i >> 4, n4 = (i & 15) * 4; tb[q] = *(const f32x4*)(wout + (size_t)(256 + g * 64 + m) * 1024 + ntile * 64 + n4); }
#pragma unroll
          for (int q = 0; q < 2; ++q) { const int i = tid + q * NTHR; *(LAS f32x4*)(As + i * 4) = ta[q] * tp[q]; *(LAS f32x4*)(Bs + i * 4) = tb[q]; } }
      }
      __syncthreads();
      float acc[8];
#pragma unroll
      for (int i = 0; i < 8; ++i) acc[i] = 0.f;
      for (int m = 0; m < M; m += 4) {
        const float b0 = Bs[(m + 0) * 64 + lane], b1 = Bs[(m + 1) * 64 + lane], b2 = Bs[(m + 2) * 64 + lane], b3 = Bs[(m + 3) * 64 + lane];
#pragma unroll
        for (int i = 0; i < 8; ++i) { const f32x4 a = *(const LAS f32x4*)(As + (wave * 8 + i) * M + m); acc[i] += a[0] * b0 + a[1] * b1 + a[2] * b2 + a[3] * b3; }
      }
      u32x4 o; o.x = cvt_pk_bf16(acc[0], acc[1]); o.y = cvt_pk_bf16(acc[2], acc[3]); o.z = cvt_pk_bf16(acc[4], acc[5]); o.w = cvt_pk_bf16(acc[6], acc[7]);
      *(u32x4*)(WO + ((size_t)l * 1024 + ntile * 64 + lane) * 1024 + kt * 64 + wave * 8) = o;
      __syncthreads();
    }
  }
  if (PREP_MASK & 32) {
    LAS float* scr = (LAS float*)(lds + wave * (64 * 33 * 4));
    constexpr int PER_L = 640 + 256;
    const int gw = bx * NWAVE + wave, NGW = G * NWAVE;
    for (int it = gw; it < 4 * PER_L; it += NGW) {
      const int l = it / PER_L; int r = it % PER_L;
      if (r < 640) { const int kb = r / 40, nb = r % 40;
        transpose_item(p.in[I_WIN] + (size_t)l * 1024 * 1536 + 256, 1536, kb * 64, nb * 32, (bf16_t*)(ws + WS_WP) + (size_t)l * 1280 * 1024, 1024, nb * 32, kb * 64, scr, lane); continue; }
      r -= 640;
      { const int kb = r >> 5, nb = r & 31;
        transpose_item(p.in[I_WOUT] + (size_t)l * 1024 * 1024 + (size_t)512 * 1024, 1024, kb * 64, nb * 32, (bf16_t*)(ws + WS_WO) + (size_t)l * 1024 * 1024, 1024, nb * 32, 512 + kb * 64, scr, lane); }
    }
  }
  __syncthreads();
}

__device__ __forceinline__ void moe_item_addr(CParams& p, unsigned char* ws, int l, int r, const float*& src, bf16_t*& dst, int& k0, int& n0, int& drow0) {
  const int e = r / 1536, q = r % 1536, mat = q >> 9, item = q & 511, kb = item >> 5, nb = item & 31;
  n0 = nb * 32; k0 = kb * 64;
  const size_t eoff = (size_t)e * 1024 * 1024, goff = ((size_t)l * 16 + e) * 1024 * 1024;
  if (mat == 2) { src = p.in[I_WDOWN] + goff; dst = (bf16_t*)(ws + ((l & 1) ? WS_WD2 : WS_WD)) + eoff; drow0 = n0; }
  else { src = (mat ? p.in[I_WUP] : p.in[I_WGATE]) + goff; dst = (bf16_t*)(ws + ((l & 1) ? WS_WGU2 : WS_WGU)) + eoff * 2; drow0 = (n0 >> 7) * 256 + mat * 128 + (n0 & 127); }
}
__device__ __forceinline__ void convert_moe_weights(int l, int rank, int nranks, int lo, int hi, LAS unsigned char* lds) {
  CParams& p = *kargs();
  unsigned char* ws = p.ws;
  const int tid = opaque_tid(), lane = tid & 63, wave = tid >> 6;
  LAS float* scr = (LAS float*)(lds + wave * (64 * 33 * 4));
  const int kq = lane >> 3, n4 = (lane & 7) * 4, c = lane & 7;
  const int step = nranks * NWAVE;
  int r = lo + rank * NWAVE + wave;
  f32x4 v[8];
  const float* src; bf16_t* dst; int k0, n0, drow0;
  if (r < hi) { moe_item_addr(p, ws, l, r, src, dst, k0, n0, drow0);
#pragma unroll
    for (int i = 0; i < 8; ++i) v[i] = __builtin_nontemporal_load((const f32x4*)(src + (size_t)(k0 + i * 8 + kq) * 1024 + n0 + n4)); }
  while (r < hi) {
    const int rn = r + step;
    f32x4 vn[8]; const float* srcn; bf16_t* dstn = dst; int k0n = k0, n0n = n0, drow0n = drow0;
    if (rn < hi) { moe_item_addr(p, ws, l, rn, srcn, dstn, k0n, n0n, drow0n);
#pragma unroll
      for (int i = 0; i < 8; ++i) vn[i] = __builtin_nontemporal_load((const f32x4*)(srcn + (size_t)(k0n + i * 8 + kq) * 1024 + n0n + n4)); }
    else {
#pragma unroll
      for (int i = 0; i < 8; ++i) vn[i] = v[i]; }
#pragma unroll
    for (int i = 0; i < 8; ++i) { LAS float* d = scr + (i * 8 + kq) * 33 + n4; d[0] = v[i][0]; d[1] = v[i][1]; d[2] = v[i][2]; d[3] = v[i][3]; }
    LDS_WAIT();
#pragma unroll
    for (int j = 0; j < 4; ++j) { const int n = (lane >> 3) + 8 * j; const LAS float* s = scr + (8 * c) * 33 + n;
      u32x4 o; o.x = cvt_pk_bf16(s[0 * 33], s[1 * 33]); o.y = cvt_pk_bf16(s[2 * 33], s[3 * 33]); o.z = cvt_pk_bf16(s[4 * 33], s[5 * 33]); o.w = cvt_pk_bf16(s[6 * 33], s[7 * 33]);
      *(u32x4*)(dst + (size_t)(drow0 + n) * 1024 + k0 + 8 * c) = o; }
    LDS_WAIT();
#pragma unroll
    for (int i = 0; i < 8; ++i) v[i] = vn[i];
    r = rn; dst = dstn; k0 = k0n; n0 = n0n; drow0 = drow0n;
  }
  __syncthreads();
}

__device__ __forceinline__ void moe_combine2(const int* slotrow, const bf16_t* YY, int lane, f32x4 (&a)[2][4]) {
  const int smA = lane < 16 ? slotrow[lane] : -1, smB = lane < 16 ? slotrow[16 + lane] : -1;
  unsigned mA = (unsigned)__ballot(smA >= 0), mB = (unsigned)__ballot(smB >= 0);
#pragma unroll
  for (int u = 0; u < 2; ++u)
#pragma unroll
    for (int j = 0; j < 4; ++j) a[u][j] = (f32x4){0.f, 0.f, 0.f, 0.f};
  while (mA | mB) {
    const int eA = mA ? __builtin_ctz(mA) : 0, eB = mB ? __builtin_ctz(mB) : 0;
    const bool hA = mA != 0u, hB = mB != 0u;
    mA &= mA - 1u; mB &= mB - 1u;
    const int yA = hA ? __shfl(smA, eA) : 0, yB = hB ? __shfl(smB, eB) : 0;
    const bf16_t* pA = YY + (size_t)yA * 1024 + lane * 4; const bf16_t* pB = YY + (size_t)yB * 1024 + lane * 4;
    u32x2 wA[4], wB[4];
#pragma unroll
    for (int j = 0; j < 4; ++j) { wA[j] = *(const u32x2*)(pA + 256 * j); wB[j] = *(const u32x2*)(pB + 256 * j); }
    const float fA = hA ? 1.f : 0.f, fB = hB ? 1.f : 0.f;
#pragma unroll
    for (int j = 0; j < 4; ++j) {
      a[0][j][0] += fA * __uint_as_float(wA[j].x << 16); a[0][j][1] += fA * __uint_as_float(wA[j].x & 0xffff0000u); a[0][j][2] += fA * __uint_as_float(wA[j].y << 16); a[0][j][3] += fA * __uint_as_float(wA[j].y & 0xffff0000u);
      a[1][j][0] += fB * __uint_as_float(wB[j].x << 16); a[1][j][1] += fB * __uint_as_float(wB[j].x & 0xffff0000u); a[1][j][2] += fB * __uint_as_float(wB[j].y << 16); a[1][j][3] += fB * __uint_as_float(wB[j].y & 0xffff0000u); }
  }
}

__device__ __forceinline__ void ph_mod1(int l) {
  CParams& p = *kargs();
  unsigned char* ws = p.ws;
  const int tid = opaque_tid(), lane = tid & 63, wave = tid >> 6;
  const int gw = blockIdx.x * NWAVE + wave, NGW = gridDim.x * NWAVE;
  const float* MOD = (const float*)(ws + WS_MOD);
  bf16_t* X = (bf16_t*)(ws + WS_X); const bf16_t* XMID = (const bf16_t*)(ws + WS_XMID); bf16_t* HX = (bf16_t*)(ws + WS_HX);
  const int* SLOT = (const int*)(ws + WS_SLOT); const bf16_t* YY = (const bf16_t*)(ws + WS_XS);
  const float* ng = p.in[I_N1G] + l * 1024;
  for (int pr = gw; pr < NTOK / 2; pr += NGW) {
    const int row0 = pr * 2;
    const int s = row0 < NLAT ? row0 >> 11 : 8;
    f32x4 v[2][4];
    if (l == 0) {
#pragma unroll
      for (int u = 0; u < 2; ++u) { const int row = row0 + u; const float* src = row < NLAT ? p.in[I_X] + (size_t)row * 1024 : p.in[I_CTX] + (size_t)(row - NLAT) * 1024;
#pragma unroll
        for (int j = 0; j < 4; ++j) v[u][j] = *(const f32x4*)(src + lane * 4 + 256 * j); }
    } else {
#pragma unroll
      for (int u = 0; u < 2; ++u)
#pragma unroll
        for (int j = 0; j < 4; ++j) v[u][j] = ld4bf(XMID + (size_t)(row0 + u) * 1024 + lane * 4 + 256 * j);
      f32x4 a[2][4]; moe_combine2(SLOT + (size_t)row0 * 16, YY, lane, a);
      const float* g2 = MOD + ((size_t)(l - 1) * 9 + s) * 6144 + 5120;
#pragma unroll
      for (int j = 0; j < 4; ++j) { const f32x4 g = *(const f32x4*)(g2 + lane * 4 + 256 * j); v[0][j] += g * a[0][j]; v[1][j] += g * a[1][j]; }
    }
    const float* ml = MOD + ((size_t)l * 9 + s) * 6144;
#pragma unroll
    for (int u = 0; u < 2; ++u) { const int row = row0 + u;
      float ss = 0.f;
#pragma unroll
      for (int j = 0; j < 4; ++j) { st4bf(X + (size_t)row * 1024 + lane * 4 + 256 * j, v[u][j]); ss += v[u][j][0] * v[u][j][0] + v[u][j][1] * v[u][j][1] + v[u][j][2] * v[u][j][2] + v[u][j][3] * v[u][j][3]; }
      const float r = rsqrtf(wave_sum(ss) * (1.f / 1024.f) + EPS);
#pragma unroll
      for (int j = 0; j < 4; ++j) { const int c = lane * 4 + 256 * j;
        const f32x4 g = *(const f32x4*)(ng + c), sh = *(const f32x4*)(ml + c), scl = *(const f32x4*)(ml + 1024 + c);
        const f32x4 y = v[u][j] * r * g * (scl + 1.f) + sh;
        u32x2 w; w.x = cvt_pk_bf16(y[0], y[1]); w.y = cvt_pk_bf16(y[2], y[3]);
        *(u32x2*)(HX + (size_t)row * 1024 + c) = w; } }
  }
}

__device__ __forceinline__ void ph_final() {
  CParams& p = *kargs();
  unsigned char* ws = p.ws;
  const int tid = opaque_tid(), lane = tid & 63, wave = tid >> 6;
  const int gw = blockIdx.x * NWAVE + wave, NGW = gridDim.x * NWAVE;
  const float* MOD = (const float*)(ws + WS_MOD); const bf16_t* XMID = (const bf16_t*)(ws + WS_XMID);
  const int* SLOT = (const int*)(ws + WS_SLOT); const bf16_t* YY = (const bf16_t*)(ws + WS_XS);
  for (int pr = gw; pr < NLAT / 2; pr += NGW) {
    const int row0 = pr * 2, s = row0 >> 11;
    f32x4 v[2][4];
#pragma unroll
    for (int u = 0; u < 2; ++u)
#pragma unroll
      for (int j = 0; j < 4; ++j) v[u][j] = ld4bf(XMID + (size_t)(row0 + u) * 1024 + lane * 4 + 256 * j);
    f32x4 a[2][4]; moe_combine2(SLOT + (size_t)row0 * 16, YY, lane, a);
    const float* g2 = MOD + ((size_t)(DEPTH - 1) * 9 + s) * 6144 + 5120;
#pragma unroll
    for (int j = 0; j < 4; ++j) { const f32x4 g = *(const f32x4*)(g2 + lane * 4 + 256 * j);
      *(f32x4*)(p.out + (size_t)row0 * 1024 + lane * 4 + 256 * j) = v[0][j] + g * a[0][j];
      *(f32x4*)(p.out + (size_t)(row0 + 1) * 1024 + lane * 4 + 256 * j) = v[1][j] + g * a[1][j]; }
  }
}

__device__ __forceinline__ void unpack8(const u32x4 w, float (&f)[8]) {
  f[0] = __uint_as_float(w.x << 16); f[1] = __uint_as_float(w.x & 0xffff0000u); f[2] = __uint_as_float(w.y << 16); f[3] = __uint_as_float(w.y & 0xffff0000u);
  f[4] = __uint_as_float(w.z << 16); f[5] = __uint_as_float(w.z & 0xffff0000u); f[6] = __uint_as_float(w.w << 16); f[7] = __uint_as_float(w.w & 0xffff0000u);
}
__device__ __forceinline__ u32x4 pack8(const float (&f)[8]) { u32x4 o; o.x = cvt_pk_bf16(f[0], f[1]); o.y = cvt_pk_bf16(f[2], f[3]); o.z = cvt_pk_bf16(f[4], f[5]); o.w = cvt_pk_bf16(f[6], f[7]); return o; }
__device__ __forceinline__ u32x4 head_norm_rope(const u32x4 w, const float (&g)[8], const bool rope, const f32x4 c0, const f32x4 c1, const f32x4 s0, const f32x4 s1, const float sgn) {
  float f[8]; unpack8(w, f);
  float ss = 0.f;
#pragma unroll
  for (int k = 0; k < 8; ++k) ss += f[k] * f[k];
  ss += __shfl_xor(ss, 1); ss += __shfl_xor(ss, 2); ss += __shfl_xor(ss, 4); ss += __shfl_xor(ss, 8);
  const float r = rsqrtf(ss * (1.f / 128.f) + EPS);
#pragma unroll
  for (int k = 0; k < 8; ++k) f[k] *= r * g[k];
  if (rope) { float o[8];
#pragma unroll
    for (int k = 0; k < 8; ++k) { const float pk = __shfl_xor(f[k], 4); const float cs = k < 4 ? c0[k & 3] : c1[k & 3], sn = k < 4 ? s0[k & 3] : s1[k & 3]; o[k] = f[k] * cs + sgn * pk * sn; }
    return pack8(o); }
  return pack8(f);
}
__device__ __forceinline__ void ph_post(int l, LAS unsigned char* lds) {
  CParams& p = *kargs();
  unsigned char* ws = p.ws;
  const int tid = opaque_tid(), lane = tid & 63, wave = tid >> 6;
  const int gw = blockIdx.x * NWAVE + wave, NGW = gridDim.x * NWAVE;
  const bf16_t* PX = (const bf16_t*)(ws + WS_PX);
  bf16_t* QR = (bf16_t*)(ws + WS_QR); bf16_t* KR = (bf16_t*)(ws + WS_KR); bf16_t* VR = (bf16_t*)(ws + WS_VR); bf16_t* CAT = (bf16_t*)(ws + WS_CAT);
  const float* RC = (const float*)(ws + WS_ROPE); const float* RS = RC + 2048;
  float qg[8], kg[8];
  { const f32x4 a = *(const f32x4*)(p.in[I_QG] + l * 128 + (lane & 15) * 8), b = *(const f32x4*)(p.in[I_QG] + l * 128 + (lane & 15) * 8 + 4);
    const f32x4 c = *(const f32x4*)(p.in[I_KG] + l * 128 + (lane & 15) * 8), d = *(const f32x4*)(p.in[I_KG] + l * 128 + (lane & 15) * 8 + 4);
#pragma unroll
    for (int k = 0; k < 4; ++k) { qg[k] = a[k]; qg[4 + k] = b[k]; kg[k] = c[k]; kg[4 + k] = d[k]; } }
  const float sgn = (lane & 4) ? 1.f : -1.f;
  const int half = lane >> 5, l32 = lane & 31, gi = l32 >> 3, w2 = 1 << gi;
  { const bf16_t* YT = (const bf16_t*)(ws + WS_YT); const bf16_t* YTC = (const bf16_t*)(ws + WS_YTC); bf16_t* YF = (bf16_t*)(ws + WS_YF); bf16_t* YFC = (bf16_t*)(ws + WS_YFC);
    const int gt = blockIdx.x * NTHR + tid, ngt = gridDim.x * NTHR;
    {
      LAS bf16_t* rowbuf = (LAS bf16_t*)lds;
      LAS float* ctab = (LAS float*)(lds + 16384);
      for (int i = tid; i < 2048; i += NTHR) { const int m = i < 1024 ? i : i - 2048; ctab[i] = __cosf((float)m * (6.283185307179586f / 2048.f)); }
      constexpr float C8[8] = {1.f, 0.70710678118654752f, 0.f, -0.70710678118654752f, -1.f, -0.70710678118654752f, 0.f, 0.70710678118654752f};
      for (int rp = blockIdx.x; rp < 1024; rp += gridDim.x) {
        __syncthreads();
#pragma unroll
        for (int hh = 0; hh < 2; ++hh) { const int rr = rp * 2 + hh, bb = rr >> 8, lo = rr & 63, lc = lo <= 32 ? lo : 64 - lo, part = tid >> 8;
          const int srow = bb * 256 + ((rr >> 6) & 3) * 64 + (part ? 32 + lc : lc); const bool have = part == 0 || (lc >= 1 && lc <= 31);
          u32x4 w = (u32x4){0u, 0u, 0u, 0u}; if (have) w = *(const u32x4*)(YT + (size_t)srow * 2048 + (tid & 255) * 8);
          *(LAS u32x4*)(rowbuf + hh * 4096 + tid * 8) = w; }
        __syncthreads();
        const int h = tid >> 8, t2 = tid & 255, r = rp * 2 + h, b = r >> 8, hl = r & 255;
        const LAS bf16_t* src = rowbuf + h * 4096;
        const float sgn = (r & 63) > 32 ? -1.f : 1.f;
        float a[8], sv[8];
#pragma unroll
        for (int t1 = 0; t1 < 8; ++t1) { a[t1] = bf2f(src[256 * t1 + t2]); sv[t1] = sgn * bf2f(src[2048 + 256 * t1 + t2]); }
#pragma unroll
        for (int k1 = 0; k1 < 8; ++k1) { float xr = 0.f, xi = 0.f;
#pragma unroll
          for (int t1 = 0; t1 < 8; ++t1) { const float c = C8[(t1 * k1) & 7], sn = C8[((t1 * k1) + 6) & 7]; xr += a[t1] * c - sv[t1] * sn; xi -= a[t1] * sn + sv[t1] * c; }
          const int idx = (t2 * k1) & 2047; const float ct = ctab[idx], st = ctab[(idx + 1536) & 2047];
          bf16_t* dst = YF + (((size_t)(b * 8 + k1) * 256 + hl) * 512) + t2;
          dst[0] = f2bf(xr * ct + xi * st); dst[256] = f2bf(xi * ct - xr * st); }
      }
      __syncthreads(); }
    if (l != DEPTH - 1)
    for (int idx = gt; idx < 8 * 256 * 256; idx += ngt) { const int u = idx & 255, r = idx >> 8, lo = r & 63, lc = lo <= 32 ? lo : 64 - lo; float v;
      const bf16_t* C = YTC + (size_t)((r >> 8) * 256 + ((r >> 6) & 3) * 64 + lc) * 256; const bf16_t* S = C + 32 * 256;
      if (u <= 128) { v = bf2f(C[u]); if (u != 0 && u != 128) v += bf2f(C[256 - u]); }
      else { const int t = u - 128; v = (lc >= 1 && lc <= 31) ? (lo > 32 ? -1.f : 1.f) * (bf2f(S[t]) - bf2f(S[256 - t])) : 0.f; }
      YFC[idx] = f2bf(v); }
  }
  for (int pr = gw; pr < NTOK / 2; pr += NGW) {
    const int row0 = pr * 2;
    const bool lat = row0 < NLAT;
    const int b = lat ? row0 >> 11 : (row0 - NLAT) >> 8, t0 = lat ? row0 & 2047 : (row0 - NLAT) & 255, n = lat ? 2048 : 256;
    u32x4 kv[2];
#pragma unroll
    for (int u = 0; u < 2; ++u) { const bf16_t* px = PX + (size_t)(row0 + u) * 1280; kv[u] = *(const u32x4*)(px + 768 + lane * 8); }
    f32x4 c0[2], c1[2], s0[2], s1[2];
#pragma unroll
    for (int u = 0; u < 2; ++u) { const int t = t0 + u; const int pos = ((lane >> 3) & 1) ? (t & 63) : (t >> 6); const int o = pos * 32 + (lane & 3) * 8;
      c0[u] = *(const f32x4*)(RC + o); c1[u] = *(const f32x4*)(RC + o + 4); s0[u] = *(const f32x4*)(RS + o); s1[u] = *(const f32x4*)(RS + o + 4); }
    { const int t = t0 + half; const int lo = max(t - w2, 0), hi = min(t + w2, n);
      const bf16_t* base = PX + (size_t)(row0 - t0) * 1280 + l32 * 8;
      float acc[8], ctr[8];
#pragma unroll
      for (int k = 0; k < 8; ++k) acc[k] = 0.f;
      u32x4 wv[16];
#pragma unroll
      for (int r = 0; r < 16; ++r) { const int tr = t - 8 + r; const bool ok = tr >= lo && tr < hi; const int trc = ok ? tr : t;
        wv[r] = *(const u32x4*)(base + (size_t)trc * 1280); }
#pragma unroll
      for (int r = 0; r < 16; ++r) { const int tr = t - 8 + r; const bool ok = tr >= lo && tr < hi; float f[8]; unpack8(wv[r], f);
        if (r == 8) {
#pragma unroll
          for (int k = 0; k < 8; ++k) ctr[k] = f[k]; }
#pragma unroll
        for (int k = 0; k < 8; ++k) acc[k] += ok ? f[k] : 0.f; }
      const float ic = 1.f / (float)(hi - lo); float d[8];
#pragma unroll
      for (int k = 0; k < 8; ++k) d[k] = acc[k] * ic - ctr[k];
      *(u32x4*)(CAT + (size_t)(row0 + half) * 1024 + 256 + l32 * 8) = pack8(d); }
#pragma unroll
    for (int u = 0; u < 2; ++u) { const int row = row0 + u, t = t0 + u;
      const u32x4 kk = head_norm_rope(kv[u], kg, lat, c0[u], c1[u], s0[u], s1[u], sgn);
      const size_t kvrow = (size_t)b * KVLEN + (lat ? t : SEQ + t);
      if (lane < 32) *(u32x4*)(KR + kvrow * 256 + lane * 8) = kk; else *(u32x4*)(VR + kvrow * 256 + (lane - 32) * 8) = kv[u]; }
  }
}

__device__ __forceinline__ void ph_mod2(int l, LAS unsigned char* lds) {
  const int nrows = (l == DEPTH - 1) ? NLAT : NTOK;
  CParams& p = *kargs();
  unsigned char* ws = p.ws;
  const int tid = opaque_tid(), lane = tid & 63, wave = tid >> 6;
  const int gw = blockIdx.x * NWAVE + wave, NGW = gridDim.x * NWAVE;
  LAS float* wrt = (LAS float*)lds;
  const float* wr_g = p.in[I_WROUTER] + (size_t)l * 1024 * 16;
  for (int i = tid; i < 1024 * 16 / 4; i += NTHR) { const f32x4 w = *(const f32x4*)(wr_g + i * 4); const int c = i >> 2, e4 = (i & 3) * 4;
    wrt[(e4 + 0) * 1024 + c] = w[0]; wrt[(e4 + 1) * 1024 + c] = w[1]; wrt[(e4 + 2) * 1024 + c] = w[2]; wrt[(e4 + 3) * 1024 + c] = w[3]; }
  __syncthreads();
  const float* MOD = (const float*)(ws + WS_MOD); const bf16_t* XMID = (const bf16_t*)(ws + WS_XMID); bf16_t* HX = (bf16_t*)(ws + WS_HX);
  float* AFF = (float*)(ws + WS_AFF);
  const float* ng = p.in[I_N2G] + l * 1024;
  for (int pr = gw; pr < nrows / 2; pr += NGW) {
    const int row0 = pr * 2;
    const bool lat = row0 < NLAT; const int s = lat ? row0 >> 11 : 8;
    f32x4 y[2][4]; float ss[2];
#pragma unroll
    for (int u = 0; u < 2; ++u) { ss[u] = 0.f;
#pragma unroll
      for (int j = 0; j < 4; ++j) { y[u][j] = ld4bf(XMID + (size_t)(row0 + u) * 1024 + lane * 4 + 256 * j); ss[u] += y[u][j][0] * y[u][j][0] + y[u][j][1] * y[u][j][1] + y[u][j][2] * y[u][j][2] + y[u][j][3] * y[u][j][3]; } }
    const float r0 = rsqrtf(wave_sum(ss[0]) * (1.f / 1024.f) + EPS), r1 = rsqrtf(wave_sum(ss[1]) * (1.f / 1024.f) + EPS);
    const float* ml = MOD + ((size_t)l * 9 + s) * 6144;
    float lg[2][16];
#pragma unroll
    for (int e = 0; e < 16; ++e) { lg[0][e] = 0.f; lg[1][e] = 0.f; }
#pragma unroll 1
    for (int j = 0; j < 4; ++j) { const int c = lane * 4 + 256 * j;
      const f32x4 g = *(const f32x4*)(ng + c), sh = *(const f32x4*)(ml + 3072 + c), scl = *(const f32x4*)(ml + 4096 + c);
      y[0][j] = y[0][j] * r0 * g * (scl + 1.f) + sh; y[1][j] = y[1][j] * r1 * g * (scl + 1.f) + sh;
      st4bf(HX + (size_t)row0 * 1024 + c, y[0][j]); st4bf(HX + (size_t)(row0 + 1) * 1024 + c, y[1][j]);
#pragma unroll
      for (int e = 0; e < 16; ++e) { const f32x4 wv = *(const LAS f32x4*)(wrt + e * 1024 + c);
        lg[0][e] += y[0][j][0] * wv[0] + y[0][j][1] * wv[1] + y[0][j][2] * wv[2] + y[0][j][3] * wv[3];
        lg[1][e] += y[1][j][0] * wv[0] + y[1][j][1] * wv[1] + y[1][j][2] * wv[2] + y[1][j][3] * wv[3];
        if ((e & 7) == 7) asm volatile("" ::: "memory"); } }
#pragma unroll
    for (int u = 0; u < 2; ++u) {
      float a8[8], a4[4], a2[2];
#pragma unroll
      for (int i = 0; i < 8; ++i) { const bool hb = (lane & 32) != 0; const float snd = hb ? lg[u][i] : lg[u][8 + i], kp = hb ? lg[u][8 + i] : lg[u][i]; a8[i] = kp + __shfl_xor(snd, 32); }
#pragma unroll
      for (int i = 0; i < 4; ++i) { const bool hb = (lane & 16) != 0; const float snd = hb ? a8[i] : a8[4 + i], kp = hb ? a8[4 + i] : a8[i]; a4[i] = kp + __shfl_xor(snd, 16); }
#pragma unroll
      for (int i = 0; i < 2; ++i) { const bool hb = (lane & 8) != 0; const float snd = hb ? a4[i] : a4[2 + i], kp = hb ? a4[2 + i] : a4[i]; a2[i] = kp + __shfl_xor(snd, 8); }
      float mine; { const bool hb = (lane & 4) != 0; const float snd = hb ? a2[0] : a2[1], kp = hb ? a2[1] : a2[0]; mine = kp + __shfl_xor(snd, 4); }
      mine += __shfl_xor(mine, 1); mine += __shfl_xor(mine, 2);
      float mx = mine;
#pragma unroll
      for (int o = 4; o < 64; o <<= 1) mx = fmaxf(mx, __shfl_xor(mx, o));
      const float ex = __expf(mine - mx); float sm = ex;
#pragma unroll
      for (int o = 4; o < 64; o <<= 1) sm += __shfl_xor(sm, o);
      const float aff = ex / sm;
      const int e = ((lane >> 5) & 1) * 8 + ((lane >> 4) & 1) * 4 + ((lane >> 3) & 1) * 2 + ((lane >> 2) & 1), row = row0 + u;
      if ((lane & 3) == 0) { if (lat) AFF[((size_t)(row >> 11) * 16 + e) * 2048 + (row & 2047)] = aff;
        else { const int rc = row - NLAT; AFF[(size_t)128 * 2048 + ((size_t)(rc >> 8) * 16 + e) * 256 + (rc & 255)] = aff; } }
    }
  }
  __syncthreads();
}

__device__ __forceinline__ void ph_topk(int l, LAS unsigned char* lds) {
  const int nprob = (l == DEPTH - 1) ? 128 : 256;
  CParams& p = *kargs();
  unsigned char* ws = p.ws;
  const int tid = opaque_tid(), lane = tid & 63, wave = tid >> 6;
  LAS unsigned* hist = (LAS unsigned*)lds;
  LAS unsigned* wtot = hist + 256;
  LAS unsigned* res = hist + 272;
  const float* AFF = (const float*)(ws + WS_AFF); float* GATE = (float*)(ws + WS_GATE); int* SLOT = (int*)(ws + WS_SLOT);
  int* IDX = (int*)(ws + WS_IDX);
  for (int q = blockIdx.x; q < nprob; q += gridDim.x) {
    const bool lat = q < 128; const int qq = lat ? q : q - 128; const int b = qq >> 4, e = qq & 15;
    const int n = lat ? 2048 : 256, cap = lat ? CAPL : CAPC;
    const float* aff = AFF + (lat ? (size_t)qq * 2048 : (size_t)128 * 2048 + (size_t)qq * 256);
    const int i0 = tid * 4; const bool valid = i0 < n;
    unsigned k[4];
    { f32x4 a4 = (f32x4){0.f, 0.f, 0.f, 0.f}; if (valid) a4 = *(const f32x4*)(aff + i0);
#pragma unroll
      for (int r = 0; r < 4; ++r) k[r] = __float_as_uint(a4[r]); }
    unsigned prefix = 0u, mask = 0u, remaining = (unsigned)cap;
    for (int shift = 24; shift >= 0; shift -= 8) {
      __syncthreads();
      if (tid < 256) hist[tid] = 0u;
      __syncthreads();
      if (valid) {
#pragma unroll
        for (int r = 0; r < 4; ++r) if ((k[r] & mask) == prefix) atomicAdd((unsigned*)&hist[(k[r] >> shift) & 255u], 1u); }
      __syncthreads();
      unsigned hv = 0u, sfx = 0u;
      if (tid < 256) { hv = hist[tid]; sfx = hv;
#pragma unroll
        for (int o = 1; o < 64; o <<= 1) { const unsigned t = __shfl_down(sfx, o); if (lane + o < 64) sfx += t; }
        if (lane == 0) wtot[wave] = sfx; }
      __syncthreads();
      if (tid < 256) { unsigned above = 0u;
#pragma unroll
        for (int w = 1; w < 4; ++w) if (w > wave) above += wtot[w];
        const unsigned incl = sfx + above, excl = incl - hv;
        if (excl < remaining && remaining <= incl) { res[0] = (unsigned)tid; res[1] = remaining - excl; res[2] = hv; } }
      __syncthreads();
      prefix |= res[0] << shift; mask |= 255u << shift; remaining = res[1];
    }
    const unsigned T = prefix, need_eq = remaining, tot_eq = res[2];
    bool sel[4]; int cnt = 0;
#pragma unroll
    for (int r = 0; r < 4; ++r) { bool sl = valid && (k[r] > T || (k[r] == T && tot_eq == need_eq));
      if (valid && k[r] == T && tot_eq != need_eq) { unsigned rk = 0u; for (int j = 0; j < i0 + r; ++j) rk += (__float_as_uint(aff[j]) == T) ? 1u : 0u; sl = rk < need_eq; }
      sel[r] = sl; cnt += sl ? 1 : 0; }
    int incl = cnt;
#pragma unroll
    for (int o = 1; o < 64; o <<= 1) { const int t = __shfl_up(incl, o); if (lane >= o) incl += t; }
    __syncthreads();
    if (lane == 63) wtot[wave] = (unsigned)incl;
    __syncthreads();
    int base = incl - cnt;
#pragma unroll
    for (int w = 0; w < 8; ++w) if (w < wave) base += (int)wtot[w];
    const int tokbase = lat ? b * SEQ : NLAT + b * CTXL;
    const int yrow0 = e * EROWS + (lat ? b * CAPL : NB * CAPL + b * CAPC);
    if (valid) {
#pragma unroll
      for (int r = 0; r < 4; ++r) { const int tok = tokbase + i0 + r;
        if (sel[r]) { SLOT[(size_t)tok * 16 + e] = yrow0 + base; GATE[yrow0 + base] = __uint_as_float(k[r]); IDX[yrow0 + base] = tok; ++base; }
        else SLOT[(size_t)tok * 16 + e] = -1; } }
    __syncthreads();
  }
}

#ifndef PH_MASK
#define PH_MASK 0xFFFF
#endif
#ifndef DUP_MASK
#define DUP_MASK 0
#endif
#define REPS(bit) for (int rep_ = 0; rep_ < 1 + ((DUP_MASK & (bit)) ? 1 : 0); ++rep_)
#define GSYNC() do { xcd_barrier(xst); if (DUP_MASK & 4096) xcd_barrier(xst); } while (0)
__global__ void __launch_bounds__(NTHR, 2) fwd_mega(Params p) {
  extern __shared__ __attribute__((aligned(16))) unsigned char lds_raw[];
  LAS unsigned char* lds = (LAS unsigned char*)lds_raw;
  cg::grid_group grid = cg::this_grid();
  const int G = gridDim.x;
  const int bx = (G % 8 == 0) ? ((int)blockIdx.x % 8) * (G / 8) + (int)blockIdx.x / 8 : (int)blockIdx.x;

  volatile LAS unsigned* xst = (volatile LAS unsigned*)(lds + 131072);
  if (threadIdx.x == 0) { xst[0] = 0u; xst[1] = 0u; }
  __syncthreads();
  xcd_barrier_post((unsigned*)(kargs()->ws + WS_BAR));
  REPS(1) if (PH_MASK & 1) ph_prep(lds);
  GSYNC();
  if (gridDim.x == 0x7fffffffu) grid.sync();

  for (int l = 0; l < DEPTH; ++l) {
    const bool last = (l == DEPTH - 1);
    REPS(2) if (PH_MASK & 2) ph_mod1(l);
    GSYNC();
    REPS(4) if (PH_MASK & 4) {
      unsigned char* ws = kargs()->ws;
      pg8::Gemm g{(const bf16_t*)(ws + WS_HX), (const bf16_t*)(ws + WS_WP) + (size_t)l * 1280 * 1024, 1024, 1024, 1024};
      pg8::Sched S{72, 5, 360, G, bx, 72};
      pg8::EpiBf16 E{(bf16_t*)(ws + WS_PX), 1280};
      pg8::gemm_phase<pg8::EpiBf16>(lds, g, S, E);
    }
    REPS(4) if (PH_MASK & 8) {
      unsigned char* ws = kargs()->ws;
      pg8::Gemm g{(const bf16_t*)(ws + WS_WF) + (size_t)l * 256 * 1024, (const bf16_t*)(ws + WS_HX), 1024, 1024, 1024};
      pg8::Sched S{1, 72, 72, G, (bx + G - (360 % G)) % G, 1};
      pg8::EpiYT E{(bf16_t*)(ws + WS_YT), (bf16_t*)(ws + WS_YTC)};
      pg8::gemm_phase<pg8::EpiYT>(lds, g, S, E);
      if (G == 256 && bx >= 176 && (l == 0 || last)) convert_moe_weights(l, bx - 176, 80, l == 0 ? CONV_P : CONV_C, l == 0 ? CONV_Q : 16 * 1536, lds);
    }
    GSYNC();
    REPS(16) if (PH_MASK & 16) ph_post(l, lds);
    GSYNC();
    REPS(32) if (PH_MASK & 32) {
      unsigned char* ws = kargs()->ws;
      const bf16_t* QR = (const bf16_t*)(ws + WS_QR); const bf16_t* KR = (const bf16_t*)(ws + WS_KR); const bf16_t* VR = (const bf16_t*)(ws + WS_VR); bf16_t* CAT = (bf16_t*)(ws + WS_CAT);
      REPS(16384) for (int u = bx; u < (last ? 256 : 288); u += G) {
        const bool lat = u < 256; const int uu = lat ? u : u - 256;
        const int b = lat ? uu >> 5 : uu >> 2, h = lat ? (uu >> 3) & 3 : uu & 3, qb = lat ? uu & 7 : 0;
        const size_t tok = lat ? (size_t)b * SEQ + qb * 256 : (size_t)NLAT + b * CTXL;
        const size_t kv = ((size_t)b * KVLEN + (lat ? 0 : SEQ)) * 256 + (h >> 1) * 128;
        att::attn_dense_body((const bf16_t*)(ws + WS_PX) + tok * 1280 + 256 + h * 128, KR + kv, VR + kv, CAT + tok * 1024 + 512 + h * 128, lat ? KVLEN : CTXL, (char*)lds_raw,
                             kargs()->in[I_QG] + l * 128, (const float*)(ws + WS_ROPE), (const float*)(ws + WS_ROPE) + 2048, lat, qb * 256);
      }
      { pg8::Gemm g{(const bf16_t*)(ws + WS_DFTM), (const bf16_t*)(ws + WS_YF), 512, 512, 512};
        pg8::Sched S{1, 64, 64, G, (bx + G - (32 % G)) % G, 1};
        pg8::EpiDft2 E{CAT, 0.0027621358640099515f};
        pg8::gemm_phase<pg8::EpiDft2>(lds, g, S, E); }
      { pg8::Gemm g{(const bf16_t*)(ws + WS_DFTC), (const bf16_t*)(ws + WS_YFC), 256, 256, 256};
        pg8::Sched S{1, 8, last ? 0 : 8, G, (bx + G - (96 % G)) % G, 1};
        pg8::EpiDft E{CAT, NLAT, CTXL, 0.0078125f};
        pg8::gemm_phase<pg8::EpiDft>(lds, g, S, E); }
      { const int cq = (bx + G - (32 % G)) % G;
        const int clo = (G == 256) ? (l == 0 ? CONV_Q : (last ? 16 * 1536 : CONV_B)) : 0;
        const int chi = (last || G != 256) ? 16 * 1536 : (l == 0 ? CONV_SPLIT : CONV_B);
        const int s1 = (G <= 72) ? chi : clo + ((chi - clo) / 4) * 3;
        if (chi > clo) { convert_moe_weights(l, bx, G, clo, s1, lds);
          if (G > 72 && cq >= 72) convert_moe_weights(l, cq - 72, G - 72, s1, chi, lds); } }
    }
    GSYNC();
    REPS(64) if (PH_MASK & 64) {
      unsigned char* ws = kargs()->ws;
      pg8::Gemm g{(const bf16_t*)(ws + WS_CAT), (const bf16_t*)(ws + WS_WO) + (size_t)l * 1024 * 1024, 1024, 1024, 1024};
      pg8::Sched S{last ? 64 : 72, 4, last ? 256 : 288, G, bx, 72};
      pg8::EpiOut E{(const bf16_t*)(ws + WS_X), (bf16_t*)(ws + WS_XMID), (const float*)(ws + WS_MOD) + (size_t)l * 9 * 6144};
      pg8::gemm_phase<pg8::EpiOut>(lds, g, S, E);
      if (!last && G == 256 && bx >= 32) { convert_moe_weights(l, bx - 32, G - 32, l == 0 ? CONV_SPLIT : CONV_B, 16 * 1536, lds);
        if (l == DEPTH - 2) convert_moe_weights(l + 1, bx - 32, G - 32, CONV_B, CONV_C, lds); }
    }
    GSYNC();
    REPS(128) if (PH_MASK & 128) ph_mod2(l, lds);
    GSYNC();
    REPS(256) if (PH_MASK & 256) ph_topk(l, lds);
    GSYNC();
    REPS(512) if (PH_MASK & 512) {
      unsigned char* ws = kargs()->ws;
      pg8::Gemm g{(const bf16_t*)(ws + WS_HX), (const bf16_t*)(ws + ((l & 1) ? WS_WGU2 : WS_WGU)), 1024, 1024, 1024};
      pg8::Sched S{last ? 8 : 9, 8, last ? 16 * 64 : 16 * 72, G, bx, 9};
      pg8::EpiMoe1 E{(bf16_t*)(ws + WS_HH)};
      pg8::gemm_phase_gather<pg8::EpiMoe1>(lds, g, (const int*)(ws + WS_IDX), S, E);
      if (!last && G == 256 && bx >= 128) convert_moe_weights(l + 1, bx - 128, 128, 0, CONV_A, lds);
    }
    GSYNC();
    REPS(1024) if (PH_MASK & 1024) {
      unsigned char* ws = kargs()->ws;
      pg8::Gemm g{(const bf16_t*)(ws + WS_HH), (const bf16_t*)(ws + ((l & 1) ? WS_WD2 : WS_WD)), 1024, 1024, 1024};
      pg8::Sched S{last ? 8 : 9, 4, last ? 16 * 32 : 16 * 36, G, bx, 9};
      pg8::EpiMoe2 E{(bf16_t*)(ws + WS_XS), (const float*)(ws + WS_GATE)};
      pg8::gemm_phase<pg8::EpiMoe2>(lds, g, S, E);
      if (!last && G == 256 && bx >= 64) convert_moe_weights(l + 1, bx - 64, 192, CONV_A, CONV_B, lds);
    }
    GSYNC();
  }
  if (PH_MASK & 2048) ph_final();
}

extern "C" void kernel_launch(void* const* d_in, const int* in_sizes, int n_in, void* d_out, int out_size,
                              void* d_ws, size_t ws_size, hipStream_t stream) {
  static int grid_blocks = 0;
  if (grid_blocks == 0) {
    if (n_in != N_IN || out_size != NLAT * DM || ws_size < WS_END) {
      fprintf(stderr, "kernel_launch: unexpected shapes: n_in %d out %d ws %zu (need %zu)\n", n_in, out_size, ws_size, (size_t)WS_END); grid_blocks = -1; return; }
    int dev = 0, cus = 0, per_cu = 0;
    if (hipGetDevice(&dev) != hipSuccess || hipDeviceGetAttribute(&cus, hipDeviceAttributeMultiprocessorCount, dev) != hipSuccess) { grid_blocks = -1; return; }
    if (hipFuncSetAttribute((const void*)fwd_mega, hipFuncAttributeMaxDynamicSharedMemorySize, LDS_BYTES) != hipSuccess) { fprintf(stderr, "kernel_launch: hipFuncSetAttribute failed\n"); grid_blocks = -1; return; }
    if (hipOccupancyMaxActiveBlocksPerMultiprocessor(&per_cu, (const void*)fwd_mega, NTHR, LDS_BYTES) != hipSuccess || per_cu < 1) { fprintf(stderr, "kernel_launch: occupancy query says %d\n", per_cu); per_cu = 1; }
    (void)hipGetLastError();
    grid_blocks = cus;
  }
  if (grid_blocks < 0) return;
  Params p{};
  for (int i = 0; i < N_IN; ++i) p.in[i] = (const float*)d_in[i];
  p.out = (float*)d_out; p.ws = (unsigned char*)d_ws;
  if (hipMemsetAsync((char*)d_ws + WS_BAR, 0, 16384, stream) != hipSuccess) { fprintf(stderr, "kernel_launch: memset failed\n"); return; }
  void* args[] = {&p};
  hipError_t e = hipLaunchCooperativeKernel((void*)fwd_mega, dim3(grid_blocks), dim3(NTHR), args, LDS_BYTES, stream);
  if (e != hipSuccess) fprintf(stderr, "cooperative launch failed: %s (grid %d)\n", hipGetErrorString(e), grid_blocks);
}
```
